# Optimizing an MI355X kernel written in HIP

```python
import jax, jax.numpy as jnp
from jax import lax
import numpy as np

D_MODEL = 1024
BATCH = 1
SEQ = 16384
DEPTH = 2

D_MIX = D_MODEL
W_A = D_MIX // 4
W_B = D_MIX // 4
W_C = D_MIX // 4
W_D = D_MIX // 4
SHORT_CONV = 3
POOL_WINDOWS = (2, 4, 8, 16)
N_POOL_GROUPS = len(POOL_WINDOWS)
POOL_GROUP_DIM = W_B // N_POOL_GROUPS
CONF_WIDTH = 31
SGU_CHUNK = 128
N_HEADS_D = 4
SGU_HEAD_DIM = W_D // N_HEADS_D
IN_SIZES = (W_A, W_A, W_A, W_A,
            W_B, W_B,
            W_C, W_C, W_C,
            W_D, W_D, W_D)
D_IN = sum(IN_SIZES)
EPS = 1e-6

kernel_name = "hybrid_parallel_conv_pool_conformer_sgu"


def rms_norm(x, g):
    xf = x.astype(jnp.float32)
    y = xf * lax.rsqrt(jnp.mean(xf * xf, axis=-1, keepdims=True) + EPS)
    return (y * g.astype(jnp.float32)).astype(x.dtype)


def layer_norm(x, g, b):
    xf = x.astype(jnp.float32)
    mu = jnp.mean(xf, axis=-1, keepdims=True)
    var = jnp.mean(jnp.square(xf - mu), axis=-1, keepdims=True)
    y = (xf - mu) * lax.rsqrt(var + EPS)
    return (y * g.astype(jnp.float32) + b.astype(jnp.float32)).astype(x.dtype)


def causal_dwconv(x, w):
    k = w.shape[0]
    xp = jnp.pad(x, ((0, 0), (k - 1, 0), (0, 0)))
    return lax.conv_general_dilated(
        xp, w[:, None, :].astype(x.dtype), window_strides=(1,), padding='VALID',
        dimension_numbers=('NWC', 'WIO', 'NWC'), feature_group_count=x.shape[-1])


def short_conv_mixer(b_gate, c_gate, xt, w_conv):
    return b_gate * causal_dwconv(c_gate * xt, w_conv)


def multiscale_pool_mixer(p, w_pool, pool_scale):
    bsz, t_len, _ = p.shape
    pf = p.astype(jnp.float32)
    t_idx = jnp.arange(t_len)
    outs = []
    for grp, w in zip(jnp.split(pf, N_POOL_GROUPS, axis=-1), POOL_WINDOWS):
        cs = jnp.pad(jnp.cumsum(grp, axis=1), ((0, 0), (w, 0), (0, 0)))
        wsum = cs[:, w:] - cs[:, :t_len]
        count = jnp.minimum(t_idx + 1, w).astype(jnp.float32)[None, :, None]
        outs.append(wsum / count - grp)
    pooled = jnp.stack(outs, axis=2).astype(p.dtype)
    y = jnp.einsum('btgc,gcd->btgd', pooled, w_pool).reshape(bsz, t_len, W_B)
    return y * pool_scale


def conformer_conv_mixer(a, gl, w_dw, b_dw, ln_g, ln_b, w_pw2, b_pw2):
    h = a * jax.nn.sigmoid(gl)
    h = causal_dwconv(h, w_dw) + b_dw
    h = jax.nn.silu(layer_norm(h, ln_g, ln_b))
    return h @ w_pw2 + b_pw2


def chunked_sgu_mixer(u, v, ln_g, ln_b, w_s, b_s):
    u = jax.nn.gelu(u)
    v = layer_norm(jax.nn.gelu(v), ln_g, ln_b)
    bsz, t_len, _ = v.shape
    n_chunks = t_len // SGU_CHUNK
    vc = v.reshape(bsz, n_chunks, SGU_CHUNK, N_HEADS_D, SGU_HEAD_DIM)
    mask = jnp.tril(jnp.ones((SGU_CHUNK, SGU_CHUNK), dtype=bool))
    ws = jnp.where(mask[None], w_s, 0)
    mixed = jnp.einsum('hst,bnthc->bnshc', ws, vc) + b_s.T[None, None, :, :, None]
    return u * mixed.reshape(bsz, t_len, W_D)


def setup_inputs(seed: int = 0) -> dict:
    key = jax.random.key(seed)
    ks = jax.random.split(key, 24)
    f32 = jnp.float32
    nrm = lambda k, shape, s: jax.random.normal(k, shape, f32) * s
    return {
        "x": nrm(ks[0], (BATCH, SEQ, D_MODEL), 1.0),
        "c": nrm(ks[1], (BATCH, D_MODEL), 1.0),
        "norm_g": 1.0 + nrm(ks[2], (DEPTH, D_MODEL), 0.02),
        "w_ada": nrm(ks[3], (DEPTH, D_MODEL, 3 * D_MODEL), 0.5 * D_MODEL ** -0.5),
        "b_ada": nrm(ks[4], (DEPTH, 3 * D_MODEL), 0.01),
        "w_in": nrm(ks[5], (DEPTH, D_MODEL, D_IN), D_MODEL ** -0.5),
        "w_conv_a": nrm(ks[6], (DEPTH, SHORT_CONV, W_A), SHORT_CONV ** -0.5),
        "w_pool": nrm(ks[7], (DEPTH, N_POOL_GROUPS, POOL_GROUP_DIM, POOL_GROUP_DIM), POOL_GROUP_DIM ** -0.5),
        "pool_scale": 1.0 + nrm(ks[8], (DEPTH, W_B), 0.02),
        "w_dw_c": nrm(ks[9], (DEPTH, CONF_WIDTH, W_C), CONF_WIDTH ** -0.5),
        "b_dw_c": nrm(ks[10], (DEPTH, W_C), 0.01),
        "ln_g_c": 1.0 + nrm(ks[11], (DEPTH, W_C), 0.02),
        "ln_b_c": nrm(ks[12], (DEPTH, W_C), 0.01),
        "w_pw2_c": nrm(ks[13], (DEPTH, W_C, W_C), W_C ** -0.5),
        "b_pw2_c": nrm(ks[14], (DEPTH, W_C), 0.01),
        "ln_g_d": 1.0 + nrm(ks[15], (DEPTH, W_D), 0.02),
        "ln_b_d": nrm(ks[16], (DEPTH, W_D), 0.01),
        "w_s_d": nrm(ks[17], (DEPTH, N_HEADS_D, SGU_CHUNK, SGU_CHUNK), 0.5 * SGU_CHUNK ** -0.5),
        "b_s_d": 1.0 + nrm(ks[18], (DEPTH, N_HEADS_D, SGU_CHUNK), 0.02),
        "w_out": nrm(ks[19], (DEPTH, D_MIX, D_MODEL), D_MIX ** -0.5),
        "final_g": 1.0 + nrm(ks[20], (D_MODEL,), 0.02),
    }


def reference(x, c, norm_g, w_ada, b_ada, w_in, w_conv_a, w_pool, pool_scale,
              w_dw_c, b_dw_c, ln_g_c, ln_b_c, w_pw2_c, b_pw2_c,
              ln_g_d, ln_b_d, w_s_d, b_s_d, w_out, final_g):
    split_points = list(np.cumsum(IN_SIZES)[:-1])
    c_act = jax.nn.silu(c)
    for l in range(DEPTH):
        mod = c_act @ w_ada[l] + b_ada[l]
        shift, scale, gate = jnp.split(mod, 3, axis=-1)
        h = rms_norm(x, norm_g[l]) * (1.0 + scale[:, None, :]) + shift[:, None, :]
        z = h @ w_in[l]
        (a_b, a_c, a_x, a_g, b_p, b_g, c_a, c_gl, c_g,
         d_u, d_v, d_g) = jnp.split(z, split_points, axis=-1)
        y_a = short_conv_mixer(a_b, a_c, a_x, w_conv_a[l]) * jax.nn.silu(a_g)
        y_b = multiscale_pool_mixer(b_p, w_pool[l], pool_scale[l]) * jax.nn.silu(b_g)
        y_c = conformer_conv_mixer(c_a, c_gl, w_dw_c[l], b_dw_c[l], ln_g_c[l], ln_b_c[l],
                                   w_pw2_c[l], b_pw2_c[l]) * jax.nn.silu(c_g)
        y_d = chunked_sgu_mixer(d_u, d_v, ln_g_d[l], ln_b_d[l], w_s_d[l], b_s_d[l]) * jax.nn.silu(d_g)
        y = jnp.concatenate([y_a, y_b, y_c, y_d], axis=-1) @ w_out[l]
        x = x + gate[:, None, :] * y
    return rms_norm(x, final_g)
```

```cpp
#include <hip/hip_runtime.h>
#include <hip/hip_cooperative_groups.h>
#include <cstdio>
namespace cg = cooperative_groups;

#ifndef MULTI_LAUNCH
#define MULTI_LAUNCH 0
#endif

#define LAS __attribute__((address_space(3)))
typedef unsigned short bf16_t;
typedef short bf16x8 __attribute__((ext_vector_type(8)));
typedef float f32x4 __attribute__((ext_vector_type(4)));
typedef float f32x2 __attribute__((ext_vector_type(2)));
typedef unsigned u32x4 __attribute__((ext_vector_type(4)));
typedef unsigned u32x2 __attribute__((ext_vector_type(2)));

constexpr int T_ = 16384, D_ = 1024, DIN = 3072, NCHUNK = 128;
constexpr float EPS_ = 1e-6f;
constexpr int NTHR = 512;
constexpr int LDS_BYTES = 149504;

constexpr size_t MiB = 1024ull * 1024ull;
constexpr size_t WS_WIN = 0;
constexpr size_t WS_WOUT = WS_WIN + 2ull * 3072 * 1024 * 2;
constexpr size_t WS_WPW2 = WS_WOUT + 2ull * 1024 * 1024 * 2;
constexpr size_t WS_WPOOL = WS_WPW2 + 2ull * 256 * 256 * 2;
constexpr size_t WS_WS = WS_WPOOL + 2ull * 4 * 64 * 64 * 2;
constexpr size_t WS_MOD = WS_WS + 2ull * 4 * 128 * 128 * 2;
constexpr size_t WS_H = 18 * MiB;
constexpr size_t WS_Z = 50 * MiB;
constexpr size_t WS_Y = 146 * MiB;
constexpr size_t WS_X1 = 178 * MiB;
constexpr size_t WS_END = 242 * MiB;
static_assert(WS_MOD + 2 * 3072 * 4 <= WS_H, "ws map");

struct Params {
    const float *x, *c, *norm_g, *w_ada, *b_ada, *w_in, *w_conv_a, *w_pool, *pool_scale, *w_dw_c, *b_dw_c, *ln_g_c, *ln_b_c, *w_pw2_c, *b_pw2_c,
        *ln_g_d, *ln_b_d, *w_s_d, *b_s_d, *w_out, *final_g;
    float* out; unsigned char* ws; int ph_lo, ph_hi;
};

__device__ __forceinline__ unsigned cvt_pk_bf16(float lo, float hi) { unsigned r; asm("v_cvt_pk_bf16_f32 %0, %1, %2" : "=v"(r) : "v"(lo), "v"(hi)); return r; }
__device__ __forceinline__ float bf_lo(unsigned u) { return __uint_as_float(u << 16); }
__device__ __forceinline__ float bf_hi(unsigned u) { return __uint_as_float(u & 0xffff0000u); }
__device__ __forceinline__ float sigmoid_f(float x) { return __builtin_amdgcn_rcpf(1.f + __expf(-x)); }
__device__ __forceinline__ float silu_f(float x) { return x * sigmoid_f(x); }
__device__ __forceinline__ float gelu_f(float x) { return x * sigmoid_f(1.5957691216f * (x + 0.044715f * x * x * x)); }
__device__ __forceinline__ float wave_sum(float v) {
#pragma unroll
    for (int o = 32; o >= 1; o >>= 1) v += __shfl_xor(v, o);
    return v;
}
__device__ __forceinline__ void unpack8(const u32x4 v, float (&f)[8]) {
    f[0] = bf_lo(v.x); f[1] = bf_hi(v.x); f[2] = bf_lo(v.y); f[3] = bf_hi(v.y); f[4] = bf_lo(v.z); f[5] = bf_hi(v.z); f[6] = bf_lo(v.w); f[7] = bf_hi(v.w);
}
__device__ __forceinline__ u32x4 pack8(const float (&f)[8]) {
    u32x4 r; r.x = cvt_pk_bf16(f[0], f[1]); r.y = cvt_pk_bf16(f[2], f[3]); r.z = cvt_pk_bf16(f[4], f[5]); r.w = cvt_pk_bf16(f[6], f[7]); return r;
}

namespace pg8 {
constexpr int BM = 256, BK = 64, HALF = 128, HTB = HALF * BK * 2, STAGE_BYTES = 8 * HTB, NXCD = 8, WGM = 8;
__host__ __device__ __forceinline__ int lds_byte(int r, int c) { const int st = (r >> 4) * 2 + (c >> 5), rr = r & 15, cc = c & 31, ob = rr * 64 + cc * 2; return st * 1024 + (ob ^ (((ob >> 9) & 1) << 5)); }
__host__ __device__ __forceinline__ void stage_rc(int b, int& R, int& C) { const int st = b / 1024, sb = b % 1024, swz = sb ^ (((sb >> 9) & 1) << 5); R = (st >> 1) * 16 + swz / 64; C = (st & 1) * 32 + (swz % 64) / 2; }
__host__ __device__ __forceinline__ int perm32(int rho) { const int n = rho >> 4, i = rho & 15; return 8 * (i >> 2) + 4 * n + (i & 3); }
struct Unit { int pm, pn; };
struct Gemm { const bf16_t* A; const bf16_t* Bt; int M, N, K; };
struct StaticOrder {
    int nM, nN, nwg, G, c;
    __device__ void init(int M, int N, int G_, int c_) { nM = M / BM; nN = N / BM; nwg = nM * nN; G = G_; c = c_; }
    __device__ bool next(int i, Unit& u) const {
        const long L = (long)i * G + c; if (L >= nwg) return false;
        int wgid = (int)L; { const int q = nwg / NXCD, r = nwg % NXCD, xcd = wgid % NXCD, off = wgid / NXCD; wgid = (xcd < r ? xcd * (q + 1) : r * (q + 1) + (xcd - r) * q) + off; }
        const int nig = WGM * nN, gid = wgid / nig, fm = gid * WGM, gsz = (nM - fm) < WGM ? (nM - fm) : WGM;
        u.pm = fm + ((wgid % nig) % gsz); u.pn = (wgid % nig) / gsz; return true;
    }
};
struct EpiZ {
    static constexpr bool PERM = true;
    bf16_t* O; int ldc;
    __device__ __forceinline__ void operator()(const f32x4 (&acc)[2][2][4][2], const Unit& u, int wr, int wc, int fr, int fq) const {
        const int row0 = u.pm * BM + wr * 64 + fr, col0 = u.pn * BM + wc * 32 + 8 * fq;
#pragma unroll
        for (int ai = 0; ai < 2; ++ai)
#pragma unroll
            for (int m = 0; m < 4; ++m) { bf16_t* rowp = O + (size_t)(row0 + ai * HALF + m * 16) * ldc + col0;
#pragma unroll
                for (int bj = 0; bj < 2; ++bj) { const f32x4 v0 = acc[ai][bj][m][0], v1 = acc[ai][bj][m][1];
                    u32x4 w; w.x = cvt_pk_bf16(v0[0], v0[1]); w.y = cvt_pk_bf16(v0[2], v0[3]); w.z = cvt_pk_bf16(v1[0], v1[1]); w.w = cvt_pk_bf16(v1[2], v1[3]);
                    *(u32x4*)(rowp + bj * HALF) = w; } }
    }
};
struct EpiRes {
    static constexpr bool PERM = false;
    const float* xin; float* xout; const float* gate;
    __device__ __forceinline__ void operator()(const f32x4 (&acc)[2][2][4][2], const Unit& u, int wr, int wc, int fr, int fq) const {
        const int row0 = u.pm * BM + wr * 64 + fr, col0 = u.pn * BM + wc * 32 + 4 * fq;
        f32x4 gv[2][2];
#pragma unroll
        for (int bj = 0; bj < 2; ++bj)
#pragma unroll
            for (int n = 0; n < 2; ++n) gv[bj][n] = *(const f32x4*)(gate + col0 + bj * HALF + n * 16);
#pragma unroll
        for (int ai = 0; ai < 2; ++ai)
#pragma unroll
            for (int m = 0; m < 4; ++m) { const size_t off = (size_t)(row0 + ai * HALF + m * 16) * D_ + col0;
#pragma unroll
                for (int bj = 0; bj < 2; ++bj)
#pragma unroll
                    for (int n = 0; n < 2; ++n) { const f32x4 xi = *(const f32x4*)(xin + off + bj * HALF + n * 16);
                        *(f32x4*)(xout + off + bj * HALF + n * 16) = xi + gv[bj][n] * acc[ai][bj][m][n]; }
                asm volatile("" ::: "memory"); }
    }
};

template <class Epi, class Sched>
__device__ __forceinline__ void gemm_phase(LAS unsigned char* lds, const Gemm g, const Sched& S, const Epi& E) {
    int tid_ = threadIdx.x; asm volatile("" : "+v"(tid_));
    const int tid = tid_, wid = __builtin_amdgcn_readfirstlane(tid >> 6), lane = tid & 63, wr = wid >> 2, wc = wid & 3, fr = lane & 15, fq = lane >> 4;
    const int K = g.K, nt = K / BK;
    unsigned voffA[2], voffB[2];
#pragma unroll
    for (int i = 0; i < 2; ++i) { int R, C; stage_rc(tid * 16 + i * 8192, R, C); const int Rb = Epi::PERM ? ((R & ~31) + perm32(R & 31)) : R;
        voffA[i] = (unsigned)(R * K + C) * 2u; voffB[i] = (unsigned)(Rb * K + C) * 2u; }
    const size_t kstep = (size_t)(BK * 2);
    const size_t hstep = (size_t)HALF * K * 2;
    const size_t tstep = 2 * hstep;
    const unsigned ldsw = (unsigned)wid * 1024u;
    const int aoff = lds_byte(wr * 64 + fr, fq * 8), boff = lds_byte(wc * 32 + fr, fq * 8);
#define PG8_SA(b, h) (((b) * 2 + (h)) * HTB)
#define PG8_SB(b, h) ((4 + (b) * 2 + (h)) * HTB)
#define PG8_STAGE(bufoff, gbase, voff) do { _Pragma("unroll") for (int _i = 0; _i < 2; ++_i) \
        __builtin_amdgcn_global_load_lds((const unsigned*)((const char*)(gbase) + (voff)[_i]), (LAS unsigned*)(lds + (bufoff) + ldsw + _i * 8192), 16, 0, 0); } while (0)
#define PG8_LDA(dst, b, h) do { _Pragma("unroll") for (int m = 0; m < 4; ++m) _Pragma("unroll") for (int k = 0; k < 2; ++k) dst[m][k] = *(const LAS bf16x8*)(lds + PG8_SA(b, h) + aoff + m * 2048 + k * 1024); } while (0)
#define PG8_LDB(dst, b, h) do { _Pragma("unroll") for (int n = 0; n < 2; ++n) _Pragma("unroll") for (int k = 0; k < 2; ++k) dst[n][k] = *(const LAS bf16x8*)(lds + PG8_SB(b, h) + boff + n * 2048 + k * 1024); } while (0)
#define PG8_MMA(ai, bj, At, Bt) do { __builtin_amdgcn_s_setprio(1); _Pragma("unroll") for (int m = 0; m < 4; ++m) _Pragma("unroll") for (int n = 0; n < 2; ++n) _Pragma("unroll") for (int k = 0; k < 2; ++k) \
        acc[ai][bj][m][n] = __builtin_amdgcn_mfma_f32_16x16x32_bf16(Bt[n][k], At[m][k], acc[ai][bj][m][n], 0, 0, 0); __builtin_amdgcn_s_setprio(0); } while (0)
#define PG8_WAIT_V(n) asm volatile("s_waitcnt vmcnt(" #n ")" ::: "memory")
#define PG8_WAIT_L(n) asm volatile("s_waitcnt lgkmcnt(" #n ")" ::: "memory")
#define PG8_BAR __builtin_amdgcn_s_barrier()
#define PG8_SCHED __builtin_amdgcn_sched_barrier(0)
    Unit cur, nxt; int ui = 0;
    if (!S.next(0, cur)) return;
    f32x4 acc[2][2][4][2];
#pragma unroll
    for (int a = 0; a < 2; ++a)
#pragma unroll
        for (int b = 0; b < 2; ++b)
#pragma unroll
            for (int m = 0; m < 4; ++m)
#pragma unroll
                for (int n = 0; n < 2; ++n) acc[a][b][m][n] = (f32x4){0.f, 0.f, 0.f, 0.f};
    bf16x8 At[4][2], B0[2][2], B1[2][2];
    const char* cA = (const char*)g.A + (size_t)cur.pm * tstep; const char* cB = (const char*)g.Bt + (size_t)cur.pn * tstep;
    PG8_STAGE(PG8_SB(0, 0), cB, voffB); PG8_STAGE(PG8_SA(0, 0), cA, voffA); PG8_STAGE(PG8_SB(0, 1), cB + hstep, voffB); PG8_STAGE(PG8_SA(0, 1), cA + hstep, voffA);
    if (wr == 1) PG8_BAR;
    PG8_WAIT_V(4); PG8_BAR;
    PG8_STAGE(PG8_SB(1, 0), cB + kstep, voffB); PG8_STAGE(PG8_SA(1, 0), cA + kstep, voffA); PG8_STAGE(PG8_SB(1, 1), cB + hstep + kstep, voffB);
    PG8_WAIT_V(6); PG8_BAR;
    for (;;) {
        const bool has_next = S.next(ui + 1, nxt);
        const char* nA = has_next ? (const char*)g.A + (size_t)nxt.pm * tstep : cA; const char* nB = has_next ? (const char*)g.Bt + (size_t)nxt.pn * tstep : cB;
        for (int t = 0; t < nt; t += 2) {
            const bool last = (t == nt - 2);
            const char* a1 = cA + (size_t)(t + 1) * kstep;
            const char* a2 = last ? nA : cA + (size_t)(t + 2) * kstep; const char* b2 = last ? nB : cB + (size_t)(t + 2) * kstep;
            const char* a3 = a2 + kstep; const char* b3 = b2 + kstep;
            PG8_LDB(B0, 0, 0); PG8_SCHED; PG8_LDA(At, 0, 0); PG8_STAGE(PG8_SA(1, 1), a1 + hstep, voffA);
            PG8_WAIT_L(8); PG8_BAR; PG8_WAIT_L(0); PG8_MMA(0, 0, At, B0); PG8_BAR; PG8_SCHED;
            PG8_LDB(B1, 0, 1); PG8_STAGE(PG8_SB(0, 0), b2, voffB);
            PG8_BAR; PG8_WAIT_L(0); PG8_MMA(0, 1, At, B1); PG8_BAR;
            PG8_LDA(At, 0, 1); PG8_STAGE(PG8_SA(0, 0), a2, voffA);
            PG8_BAR; PG8_WAIT_L(0); PG8_MMA(1, 0, At, B0); PG8_BAR; PG8_SCHED;
            PG8_STAGE(PG8_SB(0, 1), b2 + hstep, voffB);
            PG8_WAIT_V(6); PG8_BAR; PG8_MMA(1, 1, At, B1); PG8_BAR;
            PG8_LDB(B0, 1, 0); PG8_SCHED; PG8_LDA(At, 1, 0); PG8_STAGE(PG8_SA(0, 1), a2 + hstep, voffA);
            PG8_WAIT_L(8); PG8_BAR; PG8_WAIT_L(0); PG8_MMA(0, 0, At, B0); PG8_BAR; PG8_SCHED;
            PG8_LDB(B1, 1, 1); PG8_STAGE(PG8_SB(1, 0), b3, voffB);
            PG8_BAR; PG8_WAIT_L(0); PG8_MMA(0, 1, At, B1); PG8_BAR;
            PG8_LDA(At, 1, 1); PG8_STAGE(PG8_SA(1, 0), a3, voffA);
            PG8_BAR; PG8_WAIT_L(0); PG8_MMA(1, 0, At, B0); PG8_BAR; PG8_SCHED;
            PG8_STAGE(PG8_SB(1, 1), b3 + hstep, voffB);
            PG8_WAIT_V(6); PG8_BAR; PG8_MMA(1, 1, At, B1); PG8_BAR;
        }
        E(acc, cur, wr, wc, fr, fq);
        if (!has_next) break;
#pragma unroll
        for (int a = 0; a < 2; ++a)
#pragma unroll
            for (int b = 0; b < 2; ++b)
#pragma unroll
                for (int m = 0; m < 4; ++m)
#pragma unroll
                    for (int n = 0; n < 2; ++n) acc[a][b][m][n] = (f32x4){0.f, 0.f, 0.f, 0.f};
        cur = nxt; cA = nA; cB = nB; ++ui;
    }
    PG8_WAIT_V(0);
    if (wr == 0) PG8_BAR;
    PG8_BAR;
#undef PG8_SA
#undef PG8_SB
#undef PG8_STAGE
#undef PG8_LDA
#undef PG8_LDB
#undef PG8_MMA
#undef PG8_WAIT_V
#undef PG8_WAIT_L
#undef PG8_BAR
#undef PG8_SCHED
}
}

__device__ __forceinline__ void transpose_tile(const float* __restrict__ src, bf16_t* __restrict__ dst, int R, int C, int r0, int c0, LAS float* tile, int tid) {
    const int cj = tid & 63, ri = tid >> 6;
#pragma unroll
    for (int i = 0; i < 8; ++i) { const int r = ri + 8 * i; tile[r * 65 + cj] = src[(size_t)(r0 + r) * C + c0 + cj]; }
    __syncthreads();
    const int rj2 = tid & 31, ci = tid >> 5;
#pragma unroll
    for (int i = 0; i < 4; ++i) { const int cc = ci + 16 * i; const float lo = tile[(2 * rj2) * 65 + cc], hi = tile[(2 * rj2 + 1) * 65 + cc];
        *(unsigned*)(dst + (size_t)(c0 + cc) * R + r0 + 2 * rj2) = cvt_pk_bf16(lo, hi); }
    __syncthreads();
}

__device__ void phase_prep(const Params& p, LAS unsigned char* lds) {
    int tid = threadIdx.x; asm volatile("" : "+v"(tid));
    LAS float* tile = (LAS float*)lds;
    unsigned char* ws = p.ws;
    constexpr int NGEMV = 192, NT_IN = 2 * 16 * 48, NT_OUT = 2 * 16 * 16, NT_PW2 = 2 * 4 * 4, NT_POOL = 8;
    constexpr int NUNITS = NGEMV + NT_IN + NT_OUT + NT_PW2 + NT_POOL;
    for (int u = blockIdx.x; u < NUNITS; u += gridDim.x) {
        asm volatile("" : "+v"(tid));
        if (u < NGEMV) {
            const int j0 = u * 32, l = j0 / DIN, jj = j0 % DIN, col = tid & 31, ks = tid >> 5;
            const float* wa = p.w_ada + ((size_t)l * D_ + ks * 64) * DIN + jj + col;
            const float* cc = p.c + ks * 64;
            float s = 0.f;
#pragma unroll 16
            for (int k = 0; k < 64; ++k) s += silu_f(cc[k]) * wa[(size_t)k * DIN];
            tile[ks * 32 + col] = s;
            __syncthreads();
            if (tid < 32) { float a = p.b_ada[l * DIN + jj + tid];
#pragma unroll
                for (int k = 0; k < 16; ++k) a += tile[k * 32 + tid];
                ((float*)(ws + WS_MOD))[l * DIN + jj + tid] = a; }
            __syncthreads();
        } else {
            int v = u - NGEMV;
            if (v < NT_IN) { const int l = v / (16 * 48), r = (v % (16 * 48)) / 48, c = v % 48;
                transpose_tile(p.w_in + (size_t)l * D_ * DIN, (bf16_t*)(ws + WS_WIN) + (size_t)l * DIN * D_, D_, DIN, r * 64, c * 64, tile, tid); continue; }
            v -= NT_IN;
            if (v < NT_OUT) { const int l = v / 256, r = (v % 256) / 16, c = v % 16;
                transpose_tile(p.w_out + (size_t)l * D_ * D_, (bf16_t*)(ws + WS_WOUT) + (size_t)l * D_ * D_, D_, D_, r * 64, c * 64, tile, tid); continue; }
            v -= NT_OUT;
            if (v < NT_PW2) { const int l = v / 16, r = (v % 16) / 4, c = v % 4;
                transpose_tile(p.w_pw2_c + (size_t)l * 65536, (bf16_t*)(ws + WS_WPW2) + (size_t)l * 65536, 256, 256, r * 64, c * 64, tile, tid); continue; }
            v -= NT_PW2;
            transpose_tile(p.w_pool + (size_t)v * 4096, (bf16_t*)(ws + WS_WPOOL) + (size_t)v * 4096, 64, 64, 0, 0, tile, tid);
        }
    }
    bf16_t* wsb = (bf16_t*)(ws + WS_WS);
    for (int i = blockIdx.x * NTHR + tid; i < 2 * 4 * 128 * 128 / 2; i += gridDim.x * NTHR) {
        const int e = i * 2, t = e & 127, s = (e >> 7) & 127;
        const f32x2 w = *(const f32x2*)(p.w_s_d + e);
        *(unsigned*)(wsb + e) = cvt_pk_bf16(t <= s ? w.x : 0.f, (t + 1) <= s ? w.y : 0.f);
    }
}

__device__ void phase_norm(const Params& p, int l, const float* __restrict__ xin) {
    int tid = threadIdx.x; asm volatile("" : "+v"(tid));
    const int lane = tid & 63, wave = tid >> 6;
    const float* mod = (const float*)(p.ws + WS_MOD) + l * DIN;
    bf16_t* h = (bf16_t*)(p.ws + WS_H);
    f32x4 gs[4], sh[4];
#pragma unroll
    for (int j = 0; j < 4; ++j) { const int col = (j * 64 + lane) * 4;
        const f32x4 g = *(const f32x4*)(p.norm_g + l * D_ + col), sc = *(const f32x4*)(mod + D_ + col);
        gs[j] = g * (sc + 1.0f); sh[j] = *(const f32x4*)(mod + col); }
    for (int row = blockIdx.x * 8 + wave; row < T_; row += gridDim.x * 8) {
        const float* xr = xin + (size_t)row * D_;
        f32x4 v[4]; float ss = 0.f;
#pragma unroll
        for (int j = 0; j < 4; ++j) { v[j] = *(const f32x4*)(xr + (j * 64 + lane) * 4); ss += v[j][0] * v[j][0] + v[j][1] * v[j][1] + v[j][2] * v[j][2] + v[j][3] * v[j][3]; }
        ss = wave_sum(ss);
        const float rstd = rsqrtf(ss * (1.0f / D_) + EPS_);
#pragma unroll
        for (int j = 0; j < 4; ++j) { const f32x4 o = v[j] * rstd * gs[j] + sh[j];
            u32x2 w; w.x = cvt_pk_bf16(o[0], o[1]); w.y = cvt_pk_bf16(o[2], o[3]);
            *(u32x2*)(h + (size_t)row * D_ + (j * 64 + lane) * 4) = w; }
    }
}

__device__ void phase_final(const Params& p) {
    int tid = threadIdx.x; asm volatile("" : "+v"(tid));
    const int lane = tid & 63, wave = tid >> 6;
    f32x4 gs[4];
#pragma unroll
    for (int j = 0; j < 4; ++j) gs[j] = *(const f32x4*)(p.final_g + (j * 64 + lane) * 4);
    for (int row = blockIdx.x * 8 + wave; row < T_; row += gridDim.x * 8) {
        float* xr = p.out + (size_t)row * D_;
        f32x4 v[4]; float ss = 0.f;
#pragma unroll
        for (int j = 0; j < 4; ++j) { v[j] = *(const f32x4*)(xr + (j * 64 + lane) * 4); ss += v[j][0] * v[j][0] + v[j][1] * v[j][1] + v[j][2] * v[j][2] + v[j][3] * v[j][3]; }
        ss = wave_sum(ss);
        const float rstd = rsqrtf(ss * (1.0f / D_) + EPS_);
#pragma unroll
        for (int j = 0; j < 4; ++j) *(f32x4*)(xr + (j * 64 + lane) * 4) = v[j] * rstd * gs[j];
    }
}

constexpr int PST = 264;

__device__ void mix_A(const bf16_t* __restrict__ z, bf16_t* __restrict__ y, const float* __restrict__ wconv, int t0, int tid) {
    const int c8 = (tid & 31) * 8, tr = t0 + (tid >> 5) * 8;
    float w0[8], w1[8], w2[8];
#pragma unroll
    for (int j = 0; j < 8; ++j) { w0[j] = wconv[c8 + j]; w1[j] = wconv[256 + c8 + j]; w2[j] = wconv[512 + c8 + j]; }
    float p2[8], p1[8];
    {
        float a[8], b[8];
        if (tr - 2 >= 0) { unpack8(*(const u32x4*)(z + (size_t)(tr - 2) * DIN + 256 + c8), a); unpack8(*(const u32x4*)(z + (size_t)(tr - 2) * DIN + 512 + c8), b);
#pragma unroll
            for (int j = 0; j < 8; ++j) p2[j] = a[j] * b[j]; }
        else {
#pragma unroll
            for (int j = 0; j < 8; ++j) p2[j] = 0.f; }
        if (tr - 1 >= 0) { unpack8(*(const u32x4*)(z + (size_t)(tr - 1) * DIN + 256 + c8), a); unpack8(*(const u32x4*)(z + (size_t)(tr - 1) * DIN + 512 + c8), b);
#pragma unroll
            for (int j = 0; j < 8; ++j) p1[j] = a[j] * b[j]; }
        else {
#pragma unroll
            for (int j = 0; j < 8; ++j) p1[j] = 0.f; }
    }
#pragma unroll 2
    for (int i = 0; i < 8; ++i) {
        const bf16_t* zr = z + (size_t)(tr + i) * DIN + c8;
        float ab[8], ac[8], ax[8], ag[8], o[8];
        unpack8(*(const u32x4*)(zr), ab); unpack8(*(const u32x4*)(zr + 256), ac); unpack8(*(const u32x4*)(zr + 512), ax); unpack8(*(const u32x4*)(zr + 768), ag);
#pragma unroll
        for (int j = 0; j < 8; ++j) { const float pc = ac[j] * ax[j]; const float cv = w0[j] * p2[j] + w1[j] * p1[j] + w2[j] * pc;
            o[j] = ab[j] * cv * silu_f(ag[j]); p2[j] = p1[j]; p1[j] = pc; }
        *(u32x4*)(y + (size_t)(tr + i) * D_ + c8) = pack8(o);
    }
}

template <int W>
__device__ __forceinline__ void pool_window(const bf16_t* __restrict__ z, LAS bf16_t* P, int t0, int tl, int c) {
    const int tg = t0 + tl;
    u32x4 rows[W + 7];
#pragma unroll
    for (int i = 0; i < W + 7; ++i) { const int tt = tg - (W - 1) + i; rows[i] = (tt >= 0) ? *(const u32x4*)(z + (size_t)tt * DIN + 1024 + c) : (u32x4){0u, 0u, 0u, 0u}; }
    float s[8];
#pragma unroll
    for (int j = 0; j < 8; ++j) s[j] = 0.f;
#pragma unroll
    for (int i = 0; i < W - 1; ++i) { float f[8]; unpack8(rows[i], f);
#pragma unroll
        for (int j = 0; j < 8; ++j) s[j] += f[j]; }
#pragma unroll
    for (int i = 0; i < 8; ++i) {
        float f[8], o[8]; unpack8(rows[i + W - 1], f);
        const int cnt = (tg + i + 1) < W ? (tg + i + 1) : W; const float inv = 1.0f / (float)cnt;
#pragma unroll
        for (int j = 0; j < 8; ++j) { s[j] += f[j]; o[j] = s[j] * inv - f[j]; }
        *(LAS u32x4*)(P + (tl + i) * PST + c) = pack8(o);
        float f0[8]; unpack8(rows[i], f0);
#pragma unroll
        for (int j = 0; j < 8; ++j) s[j] -= f0[j];
    }
}

__device__ void mix_B(const Params& p, int l, const bf16_t* __restrict__ z, bf16_t* __restrict__ y, LAS unsigned char* lds, int t0, int tid) {
    LAS bf16_t* P = (LAS bf16_t*)lds;
    const int lane = tid & 63, wave = tid >> 6, fr = lane & 15, fq = lane >> 4;
    const int g = wave >> 1, th = wave & 1;
    {
        const int c = g * 64 + (lane & 7) * 8, tl = th * 64 + (lane >> 3) * 8;
        if (g == 0) pool_window<2>(z, P, t0, tl, c);
        else if (g == 1) pool_window<4>(z, P, t0, tl, c);
        else if (g == 2) pool_window<8>(z, P, t0, tl, c);
        else pool_window<16>(z, P, t0, tl, c);
    }
    __syncthreads();
    const bf16_t* wp = (const bf16_t*)(p.ws + WS_WPOOL) + (size_t)(l * 4 + g) * 4096;
    f32x4 acc[4][4];
#pragma unroll
    for (int m = 0; m < 4; ++m)
#pragma unroll
        for (int n = 0; n < 4; ++n) acc[m][n] = (f32x4){0.f, 0.f, 0.f, 0.f};
#pragma unroll
    for (int kk = 0; kk < 2; ++kk) {
        bf16x8 a[4], b[4];
#pragma unroll
        for (int m = 0; m < 4; ++m) a[m] = *(const LAS bf16x8*)(P + (th * 64 + m * 16 + fr) * PST + g * 64 + kk * 32 + fq * 8);
#pragma unroll
        for (int n = 0; n < 4; ++n) b[n] = *(const bf16x8*)(wp + (n * 16 + fr) * 64 + kk * 32 + fq * 8);
#pragma unroll
        for (int m = 0; m < 4; ++m)
#pragma unroll
            for (int n = 0; n < 4; ++n) acc[m][n] = __builtin_amdgcn_mfma_f32_16x16x32_bf16(b[n], a[m], acc[m][n], 0, 0, 0);
    }
    const float* psc = p.pool_scale + l * 256;
#pragma unroll
    for (int n = 0; n < 4; ++n) { const int col = g * 64 + n * 16 + 4 * fq; const f32x4 ps = *(const f32x4*)(psc + col);
#pragma unroll
        for (int m = 0; m < 4; ++m) { const int t = t0 + th * 64 + m * 16 + fr;
            const u32x2 bg = *(const u32x2*)(z + (size_t)t * DIN + 1280 + col);
            const f32x4 a = acc[m][n] * ps;
            u32x2 w; w.x = cvt_pk_bf16(a[0] * silu_f(bf_lo(bg.x)), a[1] * silu_f(bf_hi(bg.x))); w.y = cvt_pk_bf16(a[2] * silu_f(bf_lo(bg.y)), a[3] * silu_f(bf_hi(bg.y)));
            *(u32x2*)(y + (size_t)t * D_ + 256 + col) = w; } }
    __syncthreads();
}

__device__ void mix_C(const Params& p, int l, const bf16_t* __restrict__ z, bf16_t* __restrict__ y, LAS unsigned char* lds, int t0, int tid) {
    LAS bf16_t* H = (LAS bf16_t*)lds;
    LAS bf16_t* Cv = (LAS bf16_t*)(lds + 81920);
    const int lane = tid & 63, wave = tid >> 6, fr = lane & 15, fq = lane >> 4;
    for (int idx = tid; idx < 158 * 32; idx += NTHR) {
        const int r = idx >> 5, c8 = (idx & 31) * 8, tt = t0 - 30 + r;
        u32x4 o = (u32x4){0u, 0u, 0u, 0u};
        if (tt >= 0) { float a[8], gl[8], hh[8]; unpack8(*(const u32x4*)(z + (size_t)tt * DIN + 1536 + c8), a); unpack8(*(const u32x4*)(z + (size_t)tt * DIN + 1792 + c8), gl);
#pragma unroll
            for (int j = 0; j < 8; ++j) hh[j] = a[j] * sigmoid_f(gl[j]);
            o = pack8(hh); }
        *(LAS u32x4*)(H + r * 256 + c8) = o;
    }
    __syncthreads();
    {
        const int cp = tid & 127, run = tid >> 7;
        const float* wd = p.w_dw_c + (size_t)l * 31 * 256 + 2 * cp;
        f32x2 wk[31];
#pragma unroll
        for (int k = 0; k < 31; ++k) wk[k] = *(const f32x2*)(wd + k * 256);
        const f32x2 bias = *(const f32x2*)(p.b_dw_c + l * 256 + 2 * cp);
        for (int it = 0; it < 8; ++it) {
            const int tb = run * 32 + it * 4;
            f32x2 win[34];
#pragma unroll
            for (int i = 0; i < 34; ++i) { const unsigned u = *(const LAS unsigned*)(H + (tb + i) * 256 + 2 * cp); win[i] = (f32x2){bf_lo(u), bf_hi(u)}; }
#pragma unroll
            for (int j = 0; j < 4; ++j) { f32x2 a = bias;
#pragma unroll
                for (int k = 0; k < 31; ++k) a += wk[k] * win[j + k];
                *(LAS unsigned*)(Cv + (tb + j) * PST + 2 * cp) = cvt_pk_bf16(a.x, a.y); }
        }
    }
    __syncthreads();
    {
        const f32x4 g4 = *(const f32x4*)(p.ln_g_c + l * 256 + 4 * lane), b4 = *(const f32x4*)(p.ln_b_c + l * 256 + 4 * lane);
#pragma unroll 4
        for (int i = 0; i < 16; ++i) { LAS u32x2* ptr = (LAS u32x2*)(Cv + (wave * 16 + i) * PST + 4 * lane);
            const u32x2 v = *ptr; f32x4 x = (f32x4){bf_lo(v.x), bf_hi(v.x), bf_lo(v.y), bf_hi(v.y)};
            const float s = wave_sum((x[0] + x[1]) + (x[2] + x[3])), q = wave_sum((x[0] * x[0] + x[1] * x[1]) + (x[2] * x[2] + x[3] * x[3]));
            const float mean = s * (1.0f / 256.0f), var = fmaxf(q * (1.0f / 256.0f) - mean * mean, 0.f), rstd = rsqrtf(var + EPS_);
            x = (x - mean) * rstd * g4 + b4;
            u32x2 w; w.x = cvt_pk_bf16(silu_f(x[0]), silu_f(x[1])); w.y = cvt_pk_bf16(silu_f(x[2]), silu_f(x[3]));
            *ptr = w; }
    }
    __syncthreads();
    {
        const int th = wave >> 2, nq = wave & 3;
        const bf16_t* wp = (const bf16_t*)(p.ws + WS_WPW2) + (size_t)l * 65536;
        f32x4 acc[4][4];
#pragma unroll
        for (int m = 0; m < 4; ++m)
#pragma unroll
            for (int n = 0; n < 4; ++n) acc[m][n] = (f32x4){0.f, 0.f, 0.f, 0.f};
#pragma unroll 2
        for (int kk = 0; kk < 8; ++kk) {
            bf16x8 a[4], b[4];
#pragma unroll
            for (int m = 0; m < 4; ++m) a[m] = *(const LAS bf16x8*)(Cv + (th * 64 + m * 16 + fr) * PST + kk * 32 + fq * 8);
#pragma unroll
            for (int n = 0; n < 4; ++n) b[n] = *(const bf16x8*)(wp + (nq * 64 + n * 16 + fr) * 256 + kk * 32 + fq * 8);
#pragma unroll
            for (int m = 0; m < 4; ++m)
#pragma unroll
                for (int n = 0; n < 4; ++n) acc[m][n] = __builtin_amdgcn_mfma_f32_16x16x32_bf16(b[n], a[m], acc[m][n], 0, 0, 0);
        }
#pragma unroll
        for (int n = 0; n < 4; ++n) { const int col = nq * 64 + n * 16 + 4 * fq; const f32x4 bp = *(const f32x4*)(p.b_pw2_c + l * 256 + col);
#pragma unroll
            for (int m = 0; m < 4; ++m) { const int t = t0 + th * 64 + m * 16 + fr;
                const u32x2 cg_ = *(const u32x2*)(z + (size_t)t * DIN + 2048 + col);
                const f32x4 a = acc[m][n] + bp;
                u32x2 w; w.x = cvt_pk_bf16(a[0] * silu_f(bf_lo(cg_.x)), a[1] * silu_f(bf_hi(cg_.x))); w.y = cvt_pk_bf16(a[2] * silu_f(bf_lo(cg_.y)), a[3] * silu_f(bf_hi(cg_.y)));
                *(u32x2*)(y + (size_t)t * D_ + 512 + col) = w; } }
    }
    __syncthreads();
}

__device__ void mix_D(const Params& p, int l, const bf16_t* __restrict__ z, bf16_t* __restrict__ y, LAS unsigned char* lds, int t0, int tid) {
    LAS bf16_t* V = (LAS bf16_t*)lds;
    const int lane = tid & 63, wave = tid >> 6, fr = lane & 15, fq = lane >> 4;
    {
        const f32x4 g4 = *(const f32x4*)(p.ln_g_d + l * 256 + 4 * lane), b4 = *(const f32x4*)(p.ln_b_d + l * 256 + 4 * lane);
#pragma unroll 4
        for (int i = 0; i < 16; ++i) { const int t = wave * 16 + i;
            const u32x2 v = *(const u32x2*)(z + (size_t)(t0 + t) * DIN + 2560 + 4 * lane);
            f32x4 x = (f32x4){gelu_f(bf_lo(v.x)), gelu_f(bf_hi(v.x)), gelu_f(bf_lo(v.y)), gelu_f(bf_hi(v.y))};
            const float s = wave_sum((x[0] + x[1]) + (x[2] + x[3])), q = wave_sum((x[0] * x[0] + x[1] * x[1]) + (x[2] * x[2] + x[3] * x[3]));
            const float mean = s * (1.0f / 256.0f), var = fmaxf(q * (1.0f / 256.0f) - mean * mean, 0.f), rstd = rsqrtf(var + EPS_);
            x = (x - mean) * rstd * g4 + b4;
            u32x2 w; w.x = cvt_pk_bf16(x[0], x[1]); w.y = cvt_pk_bf16(x[2], x[3]);
            *(LAS u32x2*)(V + t * PST + 4 * lane) = w; }
    }
    __syncthreads();
    const int h = wave >> 1, sh = wave & 1;
    const bf16_t* wsb = (const bf16_t*)(p.ws + WS_WS) + (size_t)(l * 4 + h) * 16384;
    f32x4 acc[4][4];
#pragma unroll
    for (int m = 0; m < 4; ++m)
#pragma unroll
        for (int n = 0; n < 4; ++n) acc[m][n] = (f32x4){0.f, 0.f, 0.f, 0.f};
    const int nk = sh ? 4 : 2;
    for (int kk = 0; kk < nk; ++kk) {
        bf16x8 vf[4], wf[4];
#pragma unroll
        for (int n = 0; n < 4; ++n)
#pragma unroll
            for (int j = 0; j < 8; ++j) vf[n][j] = (short)V[(kk * 32 + fq * 8 + j) * PST + h * 64 + n * 16 + fr];
#pragma unroll
        for (int m = 0; m < 4; ++m) wf[m] = *(const bf16x8*)(wsb + (sh * 64 + m * 16 + fr) * 128 + kk * 32 + fq * 8);
#pragma unroll
        for (int m = 0; m < 4; ++m)
#pragma unroll
            for (int n = 0; n < 4; ++n) acc[m][n] = __builtin_amdgcn_mfma_f32_16x16x32_bf16(vf[n], wf[m], acc[m][n], 0, 0, 0);
    }
#pragma unroll
    for (int m = 0; m < 4; ++m) { const int s = sh * 64 + m * 16 + fr, t = t0 + s; const float bs = p.b_s_d[(l * 4 + h) * 128 + s];
#pragma unroll
        for (int n = 0; n < 4; ++n) { const int col = h * 64 + n * 16 + 4 * fq;
            const u32x2 du = *(const u32x2*)(z + (size_t)t * DIN + 2304 + col), dg = *(const u32x2*)(z + (size_t)t * DIN + 2816 + col);
            const f32x4 a = acc[m][n] + bs;
            u32x2 w; w.x = cvt_pk_bf16(gelu_f(bf_lo(du.x)) * a[0] * silu_f(bf_lo(dg.x)), gelu_f(bf_hi(du.x)) * a[1] * silu_f(bf_hi(dg.x)));
            w.y = cvt_pk_bf16(gelu_f(bf_lo(du.y)) * a[2] * silu_f(bf_lo(dg.y)), gelu_f(bf_hi(du.y)) * a[3] * silu_f(bf_hi(dg.y)));
            *(u32x2*)(y + (size_t)t * D_ + 768 + col) = w; } }
    __syncthreads();
}

__device__ void phase_mix(const Params& p, int l, LAS unsigned char* lds) {
    int tid = threadIdx.x; asm volatile("" : "+v"(tid));
    const bf16_t* z = (const bf16_t*)(p.ws + WS_Z);
    bf16_t* y = (bf16_t*)(p.ws + WS_Y);
    for (int u = blockIdx.x; u < 4 * NCHUNK; u += gridDim.x) {
        asm volatile("" : "+v"(tid));
        const int br = __builtin_amdgcn_readfirstlane(u >> 7), t0 = (u & 127) * 128;
        if (br == 0) mix_A(z, y, p.w_conv_a + l * 768, t0, tid);
        else if (br == 1) mix_B(p, l, z, y, lds, t0, tid);
        else if (br == 2) mix_C(p, l, z, y, lds, t0, tid);
        else mix_D(p, l, z, y, lds, t0, tid);
    }
}

__global__ void __launch_bounds__(NTHR, 2) mega(Params p) {
    extern __shared__ __attribute__((aligned(16))) unsigned char lds_raw[];
    LAS unsigned char* lds = (LAS unsigned char*)lds_raw;
    cg::grid_group grid = cg::this_grid();
    const int lo = p.ph_lo, hi = p.ph_hi;
#define IN(k) (lo <= (k) && (k) < hi)
#define SEAM(k) do { if (IN(k) && IN((k) + 1)) grid.sync(); } while (0)
    if (IN(0)) phase_prep(p, lds);
    SEAM(0);
    float* x1 = (float*)(p.ws + WS_X1);
    for (int l = 0; l < 2; ++l) {
        const int b = 1 + 4 * l;
        const float* xin = l ? (const float*)x1 : p.x;
        float* xout = l ? p.out : x1;
        if (IN(b)) phase_norm(p, l, xin);
        SEAM(b);
        if (IN(b + 1)) {
            pg8::Gemm g{(const bf16_t*)(p.ws + WS_H), (const bf16_t*)(p.ws + WS_WIN) + (size_t)l * DIN * D_, T_, DIN, D_};
            pg8::StaticOrder S; S.init(T_, DIN, (int)gridDim.x, (int)blockIdx.x);
            pg8::EpiZ E{(bf16_t*)(p.ws + WS_Z), DIN};
            pg8::gemm_phase(lds, g, S, E);
        }
        SEAM(b + 1);
        if (IN(b + 2)) phase_mix(p, l, lds);
        SEAM(b + 2);
        if (IN(b + 3)) {
            pg8::Gemm g{(const bf16_t*)(p.ws + WS_Y), (const bf16_t*)(p.ws + WS_WOUT) + (size_t)l * D_ * D_, T_, D_, D_};
            pg8::StaticOrder S; S.init(T_, D_, (int)gridDim.x, (int)blockIdx.x);
            pg8::EpiRes E{xin, xout, (const float*)(p.ws + WS_MOD) + l * DIN + 2 * D_};
            pg8::gemm_phase(lds, g, S, E);
        }
        SEAM(b + 3);
    }
    if (IN(9)) phase_final(p);
}

extern "C" void kernel_launch(void* const* d_in, const int* in_sizes, int n_in, void* d_out, int out_size, void* d_ws, size_t ws_size, hipStream_t stream) {
    static int grid_blocks = 0;
    if (!grid_blocks) {
        int dev = 0, cus = 0, per_cu = 0;
        hipGetDevice(&dev);
        hipDeviceGetAttribute(&cus, hipDeviceAttributeMultiprocessorCount, dev);
        if (hipFuncSetAttribute((const void*)mega, hipFuncAttributeMaxDynamicSharedMemorySize, LDS_BYTES) != hipSuccess) fprintf(stderr, "hipFuncSetAttribute failed\n");
        hipOccupancyMaxActiveBlocksPerMultiprocessor(&per_cu, (const void*)mega, NTHR, LDS_BYTES);
        if (per_cu < 1) { fprintf(stderr, "occupancy query says %d blocks/CU\n", per_cu); per_cu = 1; }
        (void)hipGetLastError();
        grid_blocks = cus * per_cu;
        if (ws_size < WS_END) fprintf(stderr, "workspace too small: %zu < %zu\n", ws_size, (size_t)WS_END);
    }
    Params p{};
    const float** pp = (const float**)&p;
    for (int i = 0; i < 21; ++i) pp[i] = (const float*)d_in[i];
    p.out = (float*)d_out; p.ws = (unsigned char*)d_ws;
#if MULTI_LAUNCH
    for (int ph = 0; ph < 10; ++ph) { p.ph_lo = ph; p.ph_hi = ph + 1; hipLaunchKernelGGL(mega, dim3(grid_blocks), dim3(NTHR), LDS_BYTES, stream, p); }
#else
    p.ph_lo = 0; p.ph_hi = 10;
    void* args[] = {&p};
    hipError_t e = hipLaunchCooperativeKernel((const void*)mega, dim3(grid_blocks), dim3(NTHR), args, LDS_BYTES, stream);
    if (e != hipSuccess) fprintf(stderr, "cooperative launch failed: %s (grid %d)\n", hipGetErrorString(e), grid_blocks);
#endif
}
```

```cpp
#include <hip/hip_runtime.h>
#include <hip/hip_cooperative_groups.h>
#include <cstdio>
namespace cg = cooperative_groups;

#ifndef MULTI_LAUNCH
#define MULTI_LAUNCH 0
#endif

#define LAS __attribute__((address_space(3)))
typedef unsigned short bf16_t;
typedef short bf16x8 __attribute__((ext_vector_type(8)));
typedef float f32x4 __attribute__((ext_vector_type(4)));
typedef float f32x2 __attribute__((ext_vector_type(2)));
typedef unsigned u32x4 __attribute__((ext_vector_type(4)));
typedef unsigned u32x2 __attribute__((ext_vector_type(2)));

constexpr int T_ = 16384, D_ = 1024, DIN = 3072, NCHUNK = 128;
constexpr float EPS_ = 1e-6f;
constexpr int NTHR = 512;
constexpr int LDS_BYTES = 149504 + 16;
constexpr int LDS_BAR_OFF = 149504;

constexpr size_t MiB = 1024ull * 1024ull;
constexpr size_t WS_WIN = 0;
constexpr size_t WS_WOUT = WS_WIN + 2ull * 3072 * 1024 * 2;
constexpr size_t WS_WPW2 = WS_WOUT + 2ull * 1024 * 1024 * 2;
constexpr size_t WS_WPOOL = WS_WPW2 + 2ull * 256 * 256 * 2;
constexpr size_t WS_WS = WS_WPOOL + 2ull * 4 * 64 * 64 * 2;
constexpr size_t WS_MOD = WS_WS + 2ull * 4 * 128 * 128 * 2;
constexpr size_t WS_BAR = WS_MOD + 2ull * 3072 * 4;
constexpr size_t WS_H = 18 * MiB;
constexpr size_t WS_Z = 50 * MiB;
constexpr size_t WS_Y = 146 * MiB;
constexpr size_t WS_X1 = 178 * MiB;
constexpr size_t WS_END = 242 * MiB;
static_assert(WS_BAR + 3456 * 4 <= WS_H, "ws map");

struct Params {
    const float *x, *c, *norm_g, *w_ada, *b_ada, *w_in, *w_conv_a, *w_pool, *pool_scale, *w_dw_c, *b_dw_c, *ln_g_c, *ln_b_c, *w_pw2_c, *b_pw2_c,
        *ln_g_d, *ln_b_d, *w_s_d, *b_s_d, *w_out, *final_g;
    float* out; unsigned char* ws; int ph_lo, ph_hi;
};

__device__ __forceinline__ unsigned cvt_pk_bf16(float lo, float hi) { unsigned r; asm("v_cvt_pk_bf16_f32 %0, %1, %2" : "=v"(r) : "v"(lo), "v"(hi)); return r; }
__device__ __forceinline__ float bf_lo(unsigned u) { return __uint_as_float(u << 16); }
__device__ __forceinline__ float bf_hi(unsigned u) { return __uint_as_float(u & 0xffff0000u); }
__device__ __forceinline__ float sigmoid_f(float x) { return __builtin_amdgcn_rcpf(1.f + __expf(-x)); }
__device__ __forceinline__ float silu_f(float x) { return x * sigmoid_f(x); }
__device__ __forceinline__ float gelu_f(float x) { return x * sigmoid_f(1.5957691216f * (x + 0.044715f * x * x * x)); }
__device__ __forceinline__ float wave_sum(float v) {
#pragma unroll
    for (int o = 32; o >= 1; o >>= 1) v += __shfl_xor(v, o);
    return v;
}
__device__ __forceinline__ void unpack8(const u32x4 v, float (&f)[8]) {
    f[0] = bf_lo(v.x); f[1] = bf_hi(v.x); f[2] = bf_lo(v.y); f[3] = bf_hi(v.y); f[4] = bf_lo(v.z); f[5] = bf_hi(v.z); f[6] = bf_lo(v.w); f[7] = bf_hi(v.w);
}
__device__ __forceinline__ u32x4 pack8(const float (&f)[8]) {
    u32x4 r; r.x = cvt_pk_bf16(f[0], f[1]); r.y = cvt_pk_bf16(f[2], f[3]); r.z = cvt_pk_bf16(f[4], f[5]); r.w = cvt_pk_bf16(f[6], f[7]); return r;
}

namespace pg8 {
constexpr int BM = 256, BK = 64, HALF = 128, HTB = HALF * BK * 2, STAGE_BYTES = 8 * HTB, NXCD = 8, WGM = 8;
__host__ __device__ __forceinline__ int lds_byte(int r, int c) { const int st = (r >> 4) * 2 + (c >> 5), rr = r & 15, cc = c & 31, ob = rr * 64 + cc * 2; return st * 1024 + (ob ^ (((ob >> 9) & 1) << 5)); }
__host__ __device__ __forceinline__ void stage_rc(int b, int& R, int& C) { const int st = b / 1024, sb = b % 1024, swz = sb ^ (((sb >> 9) & 1) << 5); R = (st >> 1) * 16 + swz / 64; C = (st & 1) * 32 + (swz % 64) / 2; }
__host__ __device__ __forceinline__ int perm32(int rho) { const int n = rho >> 4, i = rho & 15; return 8 * (i >> 2) + 4 * n + (i & 3); }
struct Unit { int pm, pn; };
struct Gemm { const bf16_t* A; const bf16_t* Bt; int M, N, K; };
struct StaticOrder {
    int nM, nN, nwg, G, c;
    __device__ void init(int M, int N, int G_, int c_) { nM = M / BM; nN = N / BM; nwg = nM * nN; G = G_; c = c_; }
    __device__ bool next(int i, Unit& u) const {
        const long L = (long)i * G + c; if (L >= nwg) return false;
        int wgid = (int)L; { const int q = nwg / NXCD, r = nwg % NXCD, xcd = wgid % NXCD, off = wgid / NXCD; wgid = (xcd < r ? xcd * (q + 1) : r * (q + 1) + (xcd - r) * q) + off; }
        const int nig = WGM * nN, gid = wgid / nig, fm = gid * WGM, gsz = (nM - fm) < WGM ? (nM - fm) : WGM;
        u.pm = fm + ((wgid % nig) % gsz); u.pn = (wgid % nig) / gsz; return true;
    }
};
struct EpiZ {
    static constexpr bool PERM = true;
    bf16_t* O; int ldc;
    __device__ __forceinline__ void operator()(const f32x4 (&acc)[2][2][4][2], const Unit& u, int wr, int wc, int fr, int fq) const {
        const int row0 = u.pm * BM + wr * 64 + fr, col0 = u.pn * BM + wc * 32 + 8 * fq;
#pragma unroll
        for (int ai = 0; ai < 2; ++ai)
#pragma unroll
            for (int m = 0; m < 4; ++m) { bf16_t* rowp = O + (size_t)(row0 + ai * HALF + m * 16) * ldc + col0;
#pragma unroll
                for (int bj = 0; bj < 2; ++bj) { const f32x4 v0 = acc[ai][bj][m][0], v1 = acc[ai][bj][m][1];
                    u32x4 w; w.x = cvt_pk_bf16(v0[0], v0[1]); w.y = cvt_pk_bf16(v0[2], v0[3]); w.z = cvt_pk_bf16(v1[0], v1[1]); w.w = cvt_pk_bf16(v1[2], v1[3]);
                    *(u32x4*)(rowp + bj * HALF) = w; } }
    }
};
struct EpiRes {
    static constexpr bool PERM = false;
    const float* xin; float* xout; const float* gate;
    __device__ __forceinline__ void operator()(const f32x4 (&acc)[2][2][4][2], const Unit& u, int wr, int wc, int fr, int fq) const {
        const int row0 = u.pm * BM + wr * 64 + fr, col0 = u.pn * BM + wc * 32 + 4 * fq;
        f32x4 gv[2][2];
#pragma unroll
        for (int bj = 0; bj < 2; ++bj)
#pragma unroll
            for (int n = 0; n < 2; ++n) gv[bj][n] = *(const f32x4*)(gate + col0 + bj * HALF + n * 16);
#pragma unroll
        for (int ai = 0; ai < 2; ++ai)
#pragma unroll
            for (int m = 0; m < 4; ++m) { const size_t off = (size_t)(row0 + ai * HALF + m * 16) * D_ + col0;
#pragma unroll
                for (int bj = 0; bj < 2; ++bj)
#pragma unroll
                    for (int n = 0; n < 2; ++n) { const f32x4 xi = *(const f32x4*)(xin + off + bj * HALF + n * 16);
                        *(f32x4*)(xout + off + bj * HALF + n * 16) = xi + gv[bj][n] * acc[ai][bj][m][n]; }
                asm volatile("" ::: "memory"); }
    }
};

template <class Epi, class Sched>
__device__ __forceinline__ void gemm_phase(LAS unsigned char* lds, const Gemm g, const Sched& S, const Epi& E) {
    int tid_ = threadIdx.x; asm volatile("" : "+v"(tid_));
    const int tid = tid_, wid = __builtin_amdgcn_readfirstlane(tid >> 6), lane = tid & 63, wr = wid >> 2, wc = wid & 3, fr = lane & 15, fq = lane >> 4;
    const int K = g.K, nt = K / BK;
    unsigned voffA[2], voffB[2];
#pragma unroll
    for (int i = 0; i < 2; ++i) { int R, C; stage_rc(tid * 16 + i * 8192, R, C); const int Rb = Epi::PERM ? ((R & ~31) + perm32(R & 31)) : R;
        voffA[i] = (unsigned)(R * K + C) * 2u; voffB[i] = (unsigned)(Rb * K + C) * 2u; }
    const size_t kstep = (size_t)(BK * 2);
    const size_t hstep = (size_t)HALF * K * 2;
    const size_t tstep = 2 * hstep;
    const unsigned ldsw = (unsigned)wid * 1024u;
    const int aoff = lds_byte(wr * 64 + fr, fq * 8), boff = lds_byte(wc * 32 + fr, fq * 8);
#define PG8_SA(b, h) (((b) * 2 + (h)) * HTB)
#define PG8_SB(b, h) ((4 + (b) * 2 + (h)) * HTB)
#define PG8_STAGE(bufoff, gbase, voff) do { _Pragma("unroll") for (int _i = 0; _i < 2; ++_i) \
        __builtin_amdgcn_global_load_lds((const unsigned*)((const char*)(gbase) + (voff)[_i]), (LAS unsigned*)(lds + (bufoff) + ldsw + _i * 8192), 16, 0, 0); } while (0)
#define PG8_LDA(dst, b, h) do { _Pragma("unroll") for (int m = 0; m < 4; ++m) _Pragma("unroll") for (int k = 0; k < 2; ++k) dst[m][k] = *(const LAS bf16x8*)(lds + PG8_SA(b, h) + aoff + m * 2048 + k * 1024); } while (0)
#define PG8_LDB(dst, b, h) do { _Pragma("unroll") for (int n = 0; n < 2; ++n) _Pragma("unroll") for (int k = 0; k < 2; ++k) dst[n][k] = *(const LAS bf16x8*)(lds + PG8_SB(b, h) + boff + n * 2048 + k * 1024); } while (0)
#define PG8_MMA(ai, bj, At, Bt) do { __builtin_amdgcn_s_setprio(1); _Pragma("unroll") for (int m = 0; m < 4; ++m) _Pragma("unroll") for (int n = 0; n < 2; ++n) _Pragma("unroll") for (int k = 0; k < 2; ++k) \
        acc[ai][bj][m][n] = __builtin_amdgcn_mfma_f32_16x16x32_bf16(Bt[n][k], At[m][k], acc[ai][bj][m][n], 0, 0, 0); __builtin_amdgcn_s_setprio(0); } while (0)
#define PG8_WAIT_V(n) asm volatile("s_waitcnt vmcnt(" #n ")" ::: "memory")
#define PG8_WAIT_L(n) asm volatile("s_waitcnt lgkmcnt(" #n ")" ::: "memory")
#define PG8_BAR __builtin_amdgcn_s_barrier()
#define PG8_SCHED __builtin_amdgcn_sched_barrier(0)
    Unit cur, nxt; int ui = 0;
    if (!S.next(0, cur)) return;
    f32x4 acc[2][2][4][2];
#pragma unroll
    for (int a = 0; a < 2; ++a)
#pragma unroll
        for (int b = 0; b < 2; ++b)
#pragma unroll
            for (int m = 0; m < 4; ++m)
#pragma unroll
                for (int n = 0; n < 2; ++n) acc[a][b][m][n] = (f32x4){0.f, 0.f, 0.f, 0.f};
    bf16x8 At[4][2], B0[2][2], B1[2][2];
    const char* cA = (const char*)g.A + (size_t)cur.pm * tstep; const char* cB = (const char*)g.Bt + (size_t)cur.pn * tstep;
    PG8_STAGE(PG8_SB(0, 0), cB, voffB); PG8_STAGE(PG8_SA(0, 0), cA, voffA); PG8_STAGE(PG8_SB(0, 1), cB + hstep, voffB); PG8_STAGE(PG8_SA(0, 1), cA + hstep, voffA);
    if (wr == 1) PG8_BAR;
    PG8_WAIT_V(4); PG8_BAR;
    PG8_STAGE(PG8_SB(1, 0), cB + kstep, voffB); PG8_STAGE(PG8_SA(1, 0), cA + kstep, voffA); PG8_STAGE(PG8_SB(1, 1), cB + hstep + kstep, voffB);
    PG8_WAIT_V(6); PG8_BAR;
    for (;;) {
        const bool has_next = S.next(ui + 1, nxt);
        const char* nA = has_next ? (const char*)g.A + (size_t)nxt.pm * tstep : cA; const char* nB = has_next ? (const char*)g.Bt + (size_t)nxt.pn * tstep : cB;
        for (int t = 0; t < nt; t += 2) {
            const bool last = (t == nt - 2);
            const char* a1 = cA + (size_t)(t + 1) * kstep;
            const char* a2 = last ? nA : cA + (size_t)(t + 2) * kstep; const char* b2 = last ? nB : cB + (size_t)(t + 2) * kstep;
            const char* a3 = a2 + kstep; const char* b3 = b2 + kstep;
            PG8_LDB(B0, 0, 0); PG8_SCHED; PG8_LDA(At, 0, 0); PG8_STAGE(PG8_SA(1, 1), a1 + hstep, voffA);
            PG8_WAIT_L(8); PG8_BAR; PG8_WAIT_L(0); PG8_MMA(0, 0, At, B0); PG8_BAR; PG8_SCHED;
            PG8_LDB(B1, 0, 1); PG8_STAGE(PG8_SB(0, 0), b2, voffB);
            PG8_BAR; PG8_WAIT_L(0); PG8_MMA(0, 1, At, B1); PG8_BAR;
            PG8_LDA(At, 0, 1); PG8_STAGE(PG8_SA(0, 0), a2, voffA);
            PG8_BAR; PG8_WAIT_L(0); PG8_MMA(1, 0, At, B0); PG8_BAR; PG8_SCHED;
            PG8_STAGE(PG8_SB(0, 1), b2 + hstep, voffB);
            PG8_WAIT_V(6); PG8_BAR; PG8_MMA(1, 1, At, B1); PG8_BAR;
            PG8_LDB(B0, 1, 0); PG8_SCHED; PG8_LDA(At, 1, 0); PG8_STAGE(PG8_SA(0, 1), a2 + hstep, voffA);
            PG8_WAIT_L(8); PG8_BAR; PG8_WAIT_L(0); PG8_MMA(0, 0, At, B0); PG8_BAR; PG8_SCHED;
            PG8_LDB(B1, 1, 1); PG8_STAGE(PG8_SB(1, 0), b3, voffB);
            PG8_BAR; PG8_WAIT_L(0); PG8_MMA(0, 1, At, B1); PG8_BAR;
            PG8_LDA(At, 1, 1); PG8_STAGE(PG8_SA(1, 0), a3, voffA);
            PG8_BAR; PG8_WAIT_L(0); PG8_MMA(1, 0, At, B0); PG8_BAR; PG8_SCHED;
            PG8_STAGE(PG8_SB(1, 1), b3 + hstep, voffB);
            PG8_WAIT_V(6); PG8_BAR; PG8_MMA(1, 1, At, B1); PG8_BAR;
        }
        E(acc, cur, wr, wc, fr, fq);
        if (!has_next) break;
#pragma unroll
        for (int a = 0; a < 2; ++a)
#pragma unroll
            for (int b = 0; b < 2; ++b)
#pragma unroll
                for (int m = 0; m < 4; ++m)
#pragma unroll
                    for (int n = 0; n < 2; ++n) acc[a][b][m][n] = (f32x4){0.f, 0.f, 0.f, 0.f};
        cur = nxt; cA = nA; cB = nB; ++ui;
    }
    PG8_WAIT_V(0);
    if (wr == 0) PG8_BAR;
    PG8_BAR;
#undef PG8_SA
#undef PG8_SB
#undef PG8_STAGE
#undef PG8_LDA
#undef PG8_LDB
#undef PG8_MMA
#undef PG8_WAIT_V
#undef PG8_WAIT_L
#undef PG8_BAR
#undef PG8_SCHED
}
}

__device__ __forceinline__ void transpose_tile(const float* __restrict__ src, bf16_t* __restrict__ dst, int R, int C, int r0, int c0, LAS float* tile, int tid) {
    const int cj = tid & 63, ri = tid >> 6;
#pragma unroll
    for (int i = 0; i < 8; ++i) { const int r = ri + 8 * i; tile[r * 65 + cj] = src[(size_t)(r0 + r) * C + c0 + cj]; }
    __syncthreads();
    const int rj2 = tid & 31, ci = tid >> 5;
#pragma unroll
    for (int i = 0; i < 4; ++i) { const int cc = ci + 16 * i; const float lo = tile[(2 * rj2) * 65 + cc], hi = tile[(2 * rj2 + 1) * 65 + cc];
        *(unsigned*)(dst + (size_t)(c0 + cc) * R + r0 + 2 * rj2) = cvt_pk_bf16(lo, hi); }
    __syncthreads();
}

__device__ void phase_prep(const Params& p, LAS unsigned char* lds) {
    int tid = threadIdx.x; asm volatile("" : "+v"(tid));
    LAS float* tile = (LAS float*)lds;
    unsigned char* ws = p.ws;
    constexpr int NGEMV = 192, NT_IN = 2 * 16 * 48, NT_OUT = 2 * 16 * 16, NT_PW2 = 2 * 4 * 4, NT_POOL = 8;
    constexpr int NUNITS = NGEMV + NT_IN + NT_OUT + NT_PW2 + NT_POOL;
    for (int u = blockIdx.x; u < NUNITS; u += gridDim.x) {
        asm volatile("" : "+v"(tid));
        if (u < NGEMV) {
            const int j0 = u * 32, l = j0 / DIN, jj = j0 % DIN, col = tid & 31, ks = tid >> 5;
            const float* wa = p.w_ada + ((size_t)l * D_ + ks * 64) * DIN + jj + col;
            const float* cc = p.c + ks * 64;
            float s = 0.f;
#pragma unroll 16
            for (int k = 0; k < 64; ++k) s += silu_f(cc[k]) * wa[(size_t)k * DIN];
            tile[ks * 32 + col] = s;
            __syncthreads();
            if (tid < 32) { float a = p.b_ada[l * DIN + jj + tid];
#pragma unroll
                for (int k = 0; k < 16; ++k) a += tile[k * 32 + tid];
                ((float*)(ws + WS_MOD))[l * DIN + jj + tid] = a; }
            __syncthreads();
        } else {
            int v = u - NGEMV;
            if (v < NT_IN) { const int l = v / (16 * 48), r = (v % (16 * 48)) / 48, c = v % 48;
                transpose_tile(p.w_in + (size_t)l * D_ * DIN, (bf16_t*)(ws + WS_WIN) + (size_t)l * DIN * D_, D_, DIN, r * 64, c * 64, tile, tid); continue; }
            v -= NT_IN;
            if (v < NT_OUT) { const int l = v / 256, r = (v % 256) / 16, c = v % 16;
                transpose_tile(p.w_out + (size_t)l * D_ * D_, (bf16_t*)(ws + WS_WOUT) + (size_t)l * D_ * D_, D_, D_, r * 64, c * 64, tile, tid); continue; }
            v -= NT_OUT;
            if (v < NT_PW2) { const int l = v / 16, r = (v % 16) / 4, c = v % 4;
                transpose_tile(p.w_pw2_c + (size_t)l * 65536, (bf16_t*)(ws + WS_WPW2) + (size_t)l * 65536, 256, 256, r * 64, c * 64, tile, tid); continue; }
            v -= NT_PW2;
            transpose_tile(p.w_pool + (size_t)v * 4096, (bf16_t*)(ws + WS_WPOOL) + (size_t)v * 4096, 64, 64, 0, 0, tile, tid);
        }
    }
    bf16_t* wsb = (bf16_t*)(ws + WS_WS);
    for (int i = blockIdx.x * NTHR + tid; i < 2 * 4 * 128 * 128 / 2; i += gridDim.x * NTHR) {
        const int e = i * 2, t = e & 127, s = (e >> 7) & 127;
        const f32x2 w = *(const f32x2*)(p.w_s_d + e);
        *(unsigned*)(wsb + e) = cvt_pk_bf16(t <= s ? w.x : 0.f, (t + 1) <= s ? w.y : 0.f);
    }
}

__device__ void phase_norm(const Params& p, int l, const float* __restrict__ xin) {
    int tid = threadIdx.x; asm volatile("" : "+v"(tid));
    const int lane = tid & 63, wave = tid >> 6;
    const float* mod = (const float*)(p.ws + WS_MOD) + l * DIN;
    bf16_t* h = (bf16_t*)(p.ws + WS_H);
    f32x4 gs[4], sh[4];
#pragma unroll
    for (int j = 0; j < 4; ++j) { const int col = (j * 64 + lane) * 4;
        const f32x4 g = *(const f32x4*)(p.norm_g + l * D_ + col), sc = *(const f32x4*)(mod + D_ + col);
        gs[j] = g * (sc + 1.0f); sh[j] = *(const f32x4*)(mod + col); }
    for (int row = blockIdx.x * 8 + wave; row < T_; row += gridDim.x * 8) {
        const float* xr = xin + (size_t)row * D_;
        f32x4 v[4]; float ss = 0.f;
#pragma unroll
        for (int j = 0; j < 4; ++j) { v[j] = *(const f32x4*)(xr + (j * 64 + lane) * 4); ss += v[j][0] * v[j][0] + v[j][1] * v[j][1] + v[j][2] * v[j][2] + v[j][3] * v[j][3]; }
        ss = wave_sum(ss);
        const float rstd = rsqrtf(ss * (1.0f / D_) + EPS_);
#pragma unroll
        for (int j = 0; j < 4; ++j) { const f32x4 o = v[j] * rstd * gs[j] + sh[j];
            u32x2 w; w.x = cvt_pk_bf16(o[0], o[1]); w.y = cvt_pk_bf16(o[2], o[3]);
            *(u32x2*)(h + (size_t)row * D_ + (j * 64 + lane) * 4) = w; }
    }
}

__device__ void phase_final(const Params& p) {
    int tid = threadIdx.x; asm volatile("" : "+v"(tid));
    const int lane = tid & 63, wave = tid >> 6;
    f32x4 gs[4];
#pragma unroll
    for (int j = 0; j < 4; ++j) gs[j] = *(const f32x4*)(p.final_g + (j * 64 + lane) * 4);
    for (int row = blockIdx.x * 8 + wave; row < T_; row += gridDim.x * 8) {
        float* xr = p.out + (size_t)row * D_;
        f32x4 v[4]; float ss = 0.f;
#pragma unroll
        for (int j = 0; j < 4; ++j) { v[j] = *(const f32x4*)(xr + (j * 64 + lane) * 4); ss += v[j][0] * v[j][0] + v[j][1] * v[j][1] + v[j][2] * v[j][2] + v[j][3] * v[j][3]; }
        ss = wave_sum(ss);
        const float rstd = rsqrtf(ss * (1.0f / D_) + EPS_);
#pragma unroll
        for (int j = 0; j < 4; ++j) *(f32x4*)(xr + (j * 64 + lane) * 4) = v[j] * rstd * gs[j];
    }
}

constexpr int PST = 264;

__device__ void mix_A(const bf16_t* __restrict__ z, bf16_t* __restrict__ y, const float* __restrict__ wconv, int t0, int tid) {
    const int c8 = (tid & 31) * 8, tr = t0 + (tid >> 5) * 8;
    float w0[8], w1[8], w2[8];
#pragma unroll
    for (int j = 0; j < 8; ++j) { w0[j] = wconv[c8 + j]; w1[j] = wconv[256 + c8 + j]; w2[j] = wconv[512 + c8 + j]; }
    float p2[8], p1[8];
    {
        float a[8], b[8];
        if (tr - 2 >= 0) { unpack8(*(const u32x4*)(z + (size_t)(tr - 2) * DIN + 256 + c8), a); unpack8(*(const u32x4*)(z + (size_t)(tr - 2) * DIN + 512 + c8), b);
#pragma unroll
            for (int j = 0; j < 8; ++j) p2[j] = a[j] * b[j]; }
        else {
#pragma unroll
            for (int j = 0; j < 8; ++j) p2[j] = 0.f; }
        if (tr - 1 >= 0) { unpack8(*(const u32x4*)(z + (size_t)(tr - 1) * DIN + 256 + c8), a); unpack8(*(const u32x4*)(z + (size_t)(tr - 1) * DIN + 512 + c8), b);
#pragma unroll
            for (int j = 0; j < 8; ++j) p1[j] = a[j] * b[j]; }
        else {
#pragma unroll
            for (int j = 0; j < 8; ++j) p1[j] = 0.f; }
    }
#pragma unroll 2
    for (int i = 0; i < 8; ++i) {
        const bf16_t* zr = z + (size_t)(tr + i) * DIN + c8;
        float ab[8], ac[8], ax[8], ag[8], o[8];
        unpack8(*(const u32x4*)(zr), ab); unpack8(*(const u32x4*)(zr + 256), ac); unpack8(*(const u32x4*)(zr + 512), ax); unpack8(*(const u32x4*)(zr + 768), ag);
#pragma unroll
        for (int j = 0; j < 8; ++j) { const float pc = ac[j] * ax[j]; const float cv = w0[j] * p2[j] + w1[j] * p1[j] + w2[j] * pc;
            o[j] = ab[j] * cv * silu_f(ag[j]); p2[j] = p1[j]; p1[j] = pc; }
        *(u32x4*)(y + (size_t)(tr + i) * D_ + c8) = pack8(o);
    }
}

template <int W>
__device__ __forceinline__ void pool_window(const bf16_t* __restrict__ z, LAS bf16_t* P, int t0, int tl, int c) {
    const int tg = t0 + tl;
    u32x4 rows[W + 7];
#pragma unroll
    for (int i = 0; i < W + 7; ++i) { const int tt = tg - (W - 1) + i; rows[i] = (tt >= 0) ? *(const u32x4*)(z + (size_t)tt * DIN + 1024 + c) : (u32x4){0u, 0u, 0u, 0u}; }
    float s[8];
#pragma unroll
    for (int j = 0; j < 8; ++j) s[j] = 0.f;
#pragma unroll
    for (int i = 0; i < W - 1; ++i) { float f[8]; unpack8(rows[i], f);
#pragma unroll
        for (int j = 0; j < 8; ++j) s[j] += f[j]; }
#pragma unroll
    for (int i = 0; i < 8; ++i) {
        float f[8], o[8]; unpack8(rows[i + W - 1], f);
        const int cnt = (tg + i + 1) < W ? (tg + i + 1) : W; const float inv = 1.0f / (float)cnt;
#pragma unroll
        for (int j = 0; j < 8; ++j) { s[j] += f[j]; o[j] = s[j] * inv - f[j]; }
        *(LAS u32x4*)(P + (tl + i) * PST + c) = pack8(o);
        float f0[8]; unpack8(rows[i], f0);
#pragma unroll
        for (int j = 0; j < 8; ++j) s[j] -= f0[j];
    }
}

__device__ void mix_B(const Params& p, int l, const bf16_t* __restrict__ z, bf16_t* __restrict__ y, LAS unsigned char* lds, int t0, int tid) {
    LAS bf16_t* P = (LAS bf16_t*)lds;
    const int lane = tid & 63, wave = tid >> 6, fr = lane & 15, fq = lane >> 4;
    const int g = wave >> 1, th = wave & 1;
    {
        const int c = g * 64 + (lane & 7) * 8, tl = th * 64 + (lane >> 3) * 8;
        if (g == 0) pool_window<2>(z, P, t0, tl, c);
        else if (g == 1) pool_window<4>(z, P, t0, tl, c);
        else if (g == 2) pool_window<8>(z, P, t0, tl, c);
        else pool_window<16>(z, P, t0, tl, c);
    }
    __syncthreads();
    const bf16_t* wp = (const bf16_t*)(p.ws + WS_WPOOL) + (size_t)(l * 4 + g) * 4096;
    f32x4 acc[4][4];
#pragma unroll
    for (int m = 0; m < 4; ++m)
#pragma unroll
        for (int n = 0; n < 4; ++n) acc[m][n] = (f32x4){0.f, 0.f, 0.f, 0.f};
#pragma unroll
    for (int kk = 0; kk < 2; ++kk) {
        bf16x8 a[4], b[4];
#pragma unroll
        for (int m = 0; m < 4; ++m) a[m] = *(const LAS bf16x8*)(P + (th * 64 + m * 16 + fr) * PST + g * 64 + kk * 32 + fq * 8);
#pragma unroll
        for (int n = 0; n < 4; ++n) b[n] = *(const bf16x8*)(wp + (n * 16 + fr) * 64 + kk * 32 + fq * 8);
#pragma unroll
        for (int m = 0; m < 4; ++m)
#pragma unroll
            for (int n = 0; n < 4; ++n) acc[m][n] = __builtin_amdgcn_mfma_f32_16x16x32_bf16(b[n], a[m], acc[m][n], 0, 0, 0);
    }
    const float* psc = p.pool_scale + l * 256;
#pragma unroll
    for (int n = 0; n < 4; ++n) { const int col = g * 64 + n * 16 + 4 * fq; const f32x4 ps = *(const f32x4*)(psc + col);
#pragma unroll
        for (int m = 0; m < 4; ++m) { const int t = t0 + th * 64 + m * 16 + fr;
            const u32x2 bg = *(const u32x2*)(z + (size_t)t * DIN + 1280 + col);
            const f32x4 a = acc[m][n] * ps;
            u32x2 w; w.x = cvt_pk_bf16(a[0] * silu_f(bf_lo(bg.x)), a[1] * silu_f(bf_hi(bg.x))); w.y = cvt_pk_bf16(a[2] * silu_f(bf_lo(bg.y)), a[3] * silu_f(bf_hi(bg.y)));
            *(u32x2*)(y + (size_t)t * D_ + 256 + col) = w; } }
    __syncthreads();
}

__device__ void mix_C(const Params& p, int l, const bf16_t* __restrict__ z, bf16_t* __restrict__ y, LAS unsigned char* lds, int t0, int tid) {
    LAS bf16_t* H = (LAS bf16_t*)lds;
    LAS bf16_t* Cv = (LAS bf16_t*)(lds + 81920);
    const int lane = tid & 63, wave = tid >> 6, fr = lane & 15, fq = lane >> 4;
    for (int idx = tid; idx < 158 * 32; idx += NTHR) {
        const int r = idx >> 5, c8 = (idx & 31) * 8, tt = t0 - 30 + r;
        u32x4 o = (u32x4){0u, 0u, 0u, 0u};
        if (tt >= 0) { float a[8], gl[8], hh[8]; unpack8(*(const u32x4*)(z + (size_t)tt * DIN + 1536 + c8), a); unpack8(*(const u32x4*)(z + (size_t)tt * DIN + 1792 + c8), gl);
#pragma unroll
            for (int j = 0; j < 8; ++j) hh[j] = a[j] * sigmoid_f(gl[j]);
            o = pack8(hh); }
        *(LAS u32x4*)(H + r * 256 + c8) = o;
    }
    __syncthreads();
    {
        const int cp = tid & 127, run = tid >> 7;
        const float* wd = p.w_dw_c + (size_t)l * 31 * 256 + 2 * cp;
        f32x2 wk[31];
#pragma unroll
        for (int k = 0; k < 31; ++k) wk[k] = *(const f32x2*)(wd + k * 256);
        const f32x2 bias = *(const f32x2*)(p.b_dw_c + l * 256 + 2 * cp);
        for (int it = 0; it < 8; ++it) {
            const int tb = run * 32 + it * 4;
            f32x2 win[34];
#pragma unroll
            for (int i = 0; i < 34; ++i) { const unsigned u = *(const LAS unsigned*)(H + (tb + i) * 256 + 2 * cp); win[i] = (f32x2){bf_lo(u), bf_hi(u)}; }
#pragma unroll
            for (int j = 0; j < 4; ++j) { f32x2 a = bias;
#pragma unroll
                for (int k = 0; k < 31; ++k) a += wk[k] * win[j + k];
                *(LAS unsigned*)(Cv + (tb + j) * PST + 2 * cp) = cvt_pk_bf16(a.x, a.y); }
        }
    }
    __syncthreads();
    {
        const f32x4 g4 = *(const f32x4*)(p.ln_g_c + l * 256 + 4 * lane), b4 = *(const f32x4*)(p.ln_b_c + l * 256 + 4 * lane);
#pragma unroll 4
        for (int i = 0; i < 16; ++i) { LAS u32x2* ptr = (LAS u32x2*)(Cv + (wave * 16 + i) * PST + 4 * lane);
            const u32x2 v = *ptr; f32x4 x = (f32x4){bf_lo(v.x), bf_hi(v.x), bf_lo(v.y), bf_hi(v.y)};
            const float s = wave_sum((x[0] + x[1]) + (x[2] + x[3])), q = wave_sum((x[0] * x[0] + x[1] * x[1]) + (x[2] * x[2] + x[3] * x[3]));
            const float mean = s * (1.0f / 256.0f), var = fmaxf(q * (1.0f / 256.0f) - mean * mean, 0.f), rstd = rsqrtf(var + EPS_);
            x = (x - mean) * rstd * g4 + b4;
            u32x2 w; w.x = cvt_pk_bf16(silu_f(x[0]), silu_f(x[1])); w.y = cvt_pk_bf16(silu_f(x[2]), silu_f(x[3]));
            *ptr = w; }
    }
    __syncthreads();
    {
        const int th = wave >> 2, nq = wave & 3;
        const bf16_t* wp = (const bf16_t*)(p.ws + WS_WPW2) + (size_t)l * 65536;
        f32x4 acc[4][4];
#pragma unroll
        for (int m = 0; m < 4; ++m)
#pragma unroll
            for (int n = 0; n < 4; ++n) acc[m][n] = (f32x4){0.f, 0.f, 0.f, 0.f};
#pragma unroll 2
        for (int kk = 0; kk < 8; ++kk) {
            bf16x8 a[4], b[4];
#pragma unroll
            for (int m = 0; m < 4; ++m) a[m] = *(const LAS bf16x8*)(Cv + (th * 64 + m * 16 + fr) * PST + kk * 32 + fq * 8);
#pragma unroll
            for (int n = 0; n < 4; ++n) b[n] = *(const bf16x8*)(wp + (nq * 64 + n * 16 + fr) * 256 + kk * 32 + fq * 8);
#pragma unroll
            for (int m = 0; m < 4; ++m)
#pragma unroll
                for (int n = 0; n < 4; ++n) acc[m][n] = __builtin_amdgcn_mfma_f32_16x16x32_bf16(b[n], a[m], acc[m][n], 0, 0, 0);
        }
#pragma unroll
        for (int n = 0; n < 4; ++n) { const int col = nq * 64 + n * 16 + 4 * fq; const f32x4 bp = *(const f32x4*)(p.b_pw2_c + l * 256 + col);
#pragma unroll
            for (int m = 0; m < 4; ++m) { const int t = t0 + th * 64 + m * 16 + fr;
                const u32x2 cg_ = *(const u32x2*)(z + (size_t)t * DIN + 2048 + col);
                const f32x4 a = acc[m][n] + bp;
                u32x2 w; w.x = cvt_pk_bf16(a[0] * silu_f(bf_lo(cg_.x)), a[1] * silu_f(bf_hi(cg_.x))); w.y = cvt_pk_bf16(a[2] * silu_f(bf_lo(cg_.y)), a[3] * silu_f(bf_hi(cg_.y)));
                *(u32x2*)(y + (size_t)t * D_ + 512 + col) = w; } }
    }
    __syncthreads();
}

__device__ void mix_D(const Params& p, int l, const bf16_t* __restrict__ z, bf16_t* __restrict__ y, LAS unsigned char* lds, int t0, int tid) {
    LAS bf16_t* V = (LAS bf16_t*)lds;
    const int lane = tid & 63, wave = tid >> 6, fr = lane & 15, fq = lane >> 4;
    {
        const f32x4 g4 = *(const f32x4*)(p.ln_g_d + l * 256 + 4 * lane), b4 = *(const f32x4*)(p.ln_b_d + l * 256 + 4 * lane);
#pragma unroll 4
        for (int i = 0; i < 16; ++i) { const int t = wave * 16 + i;
            const u32x2 v = *(const u32x2*)(z + (size_t)(t0 + t) * DIN + 2560 + 4 * lane);
            f32x4 x = (f32x4){gelu_f(bf_lo(v.x)), gelu_f(bf_hi(v.x)), gelu_f(bf_lo(v.y)), gelu_f(bf_hi(v.y))};
            const float s = wave_sum((x[0] + x[1]) + (x[2] + x[3])), q = wave_sum((x[0] * x[0] + x[1] * x[1]) + (x[2] * x[2] + x[3] * x[3]));
            const float mean = s * (1.0f / 256.0f), var = fmaxf(q * (1.0f / 256.0f) - mean * mean, 0.f), rstd = rsqrtf(var + EPS_);
            x = (x - mean) * rstd * g4 + b4;
            u32x2 w; w.x = cvt_pk_bf16(x[0], x[1]); w.y = cvt_pk_bf16(x[2], x[3]);
            *(LAS u32x2*)(V + t * PST + 4 * lane) = w; }
    }
    __syncthreads();
    const int h = wave >> 1, sh = wave & 1;
    const bf16_t* wsb = (const bf16_t*)(p.ws + WS_WS) + (size_t)(l * 4 + h) * 16384;
    f32x4 acc[4][4];
#pragma unroll
    for (int m = 0; m < 4; ++m)
#pragma unroll
        for (int n = 0; n < 4; ++n) acc[m][n] = (f32x4){0.f, 0.f, 0.f, 0.f};
    const int nk = sh ? 4 : 2;
    for (int kk = 0; kk < nk; ++kk) {
        bf16x8 vf[4], wf[4];
#pragma unroll
        for (int n = 0; n < 4; ++n)
#pragma unroll
            for (int j = 0; j < 8; ++j) vf[n][j] = (short)V[(kk * 32 + fq * 8 + j) * PST + h * 64 + n * 16 + fr];
#pragma unroll
        for (int m = 0; m < 4; ++m) wf[m] = *(const bf16x8*)(wsb + (sh * 64 + m * 16 + fr) * 128 + kk * 32 + fq * 8);
#pragma unroll
        for (int m = 0; m < 4; ++m)
#pragma unroll
            for (int n = 0; n < 4; ++n) acc[m][n] = __builtin_amdgcn_mfma_f32_16x16x32_bf16(vf[n], wf[m], acc[m][n], 0, 0, 0);
    }
#pragma unroll
    for (int m = 0; m < 4; ++m) { const int s = sh * 64 + m * 16 + fr, t = t0 + s; const float bs = p.b_s_d[(l * 4 + h) * 128 + s];
#pragma unroll
        for (int n = 0; n < 4; ++n) { const int col = h * 64 + n * 16 + 4 * fq;
            const u32x2 du = *(const u32x2*)(z + (size_t)t * DIN + 2304 + col), dg = *(const u32x2*)(z + (size_t)t * DIN + 2816 + col);
            const f32x4 a = acc[m][n] + bs;
            u32x2 w; w.x = cvt_pk_bf16(gelu_f(bf_lo(du.x)) * a[0] * silu_f(bf_lo(dg.x)), gelu_f(bf_hi(du.x)) * a[1] * silu_f(bf_hi(dg.x)));
            w.y = cvt_pk_bf16(gelu_f(bf_lo(du.y)) * a[2] * silu_f(bf_lo(dg.y)), gelu_f(bf_hi(du.y)) * a[3] * silu_f(bf_hi(dg.y)));
            *(u32x2*)(y + (size_t)t * D_ + 768 + col) = w; } }
    __syncthreads();
}

__device__ void phase_mix(const Params& p, int l, LAS unsigned char* lds) {
    int tid = threadIdx.x; asm volatile("" : "+v"(tid));
    const bf16_t* z = (const bf16_t*)(p.ws + WS_Z);
    bf16_t* y = (bf16_t*)(p.ws + WS_Y);
    for (int u = blockIdx.x; u < 4 * NCHUNK; u += gridDim.x) {
        asm volatile("" : "+v"(tid));
        const int br = __builtin_amdgcn_readfirstlane(u >> 7), t0 = (u & 127) * 128;
        if (br == 0) mix_A(z, y, p.w_conv_a + l * 768, t0, tid);
        else if (br == 1) mix_B(p, l, z, y, lds, t0, tid);
        else if (br == 2) mix_C(p, l, z, y, lds, t0, tid);
        else mix_D(p, l, z, y, lds, t0, tid);
    }
}


#define XB_TMO      128
#define XB_XCNT(j)  (256  + 64 * (j))
#define XB_XSUB(j)  (1280 + 64 * (j))
#define XB_XGEN(j)  (2304 + 64 * (j))
#define XB_TOP      3328
#define XB_TOPGEN   3392
#define XCD_BAR_WORDS 3456
#define XB_SPIN_CAP (1u << 18)
__device__ __forceinline__ unsigned xb_ld(unsigned* p)              { return __hip_atomic_load(p, __ATOMIC_RELAXED, __HIP_MEMORY_SCOPE_AGENT); }
__device__ __forceinline__ unsigned xb_add(unsigned* p, unsigned v) { return __hip_atomic_fetch_add(p, v, __ATOMIC_RELAXED, __HIP_MEMORY_SCOPE_AGENT); }
__device__ __forceinline__ unsigned xb_xcc_id() { return (unsigned)__builtin_amdgcn_s_getreg((3 << 11) | 20) & 0xFu; }
#define XB_SPIN(cond, bar) do { unsigned _sp = 0; while (cond) { __builtin_amdgcn_s_sleep(1); \
    if ((++_sp & 255u) == 0u) { if (xb_ld(&(bar)[XB_TMO])) break; if (_sp > XB_SPIN_CAP) { atomicAdd(&(bar)[XB_TMO], 1u); break; } } } } while (0)
struct XcdBarrier { unsigned* bar; unsigned x; volatile LAS unsigned* st; };
__device__ __forceinline__ XcdBarrier xcd_barrier_post(unsigned* bar, volatile LAS unsigned* st) {
    XcdBarrier b; b.bar = bar; b.x = xb_xcc_id(); b.st = st;
    if (threadIdx.x == 0) (void)xb_add(&bar[XB_XCNT(b.x)], 1u);
    return b;
}
__device__ __forceinline__ void xcd_barrier_complete(unsigned* bar, unsigned x, unsigned& nloc, unsigned& nx) {
    const unsigned G = gridDim.x * gridDim.y * gridDim.z;
    unsigned sum, cnt, mine, sp = 0u;
    for (;;) {
        sum = 0u; cnt = 0u; mine = 0u;
#pragma unroll
        for (unsigned j = 0; j < 16; ++j) { const unsigned c = xb_ld(&bar[XB_XCNT(j)]); sum += c; cnt += (c > 0u) ? 1u : 0u; mine = (j == x) ? c : mine; }
        if (sum == G) break;
        __builtin_amdgcn_s_sleep(1);
        if ((++sp & 255u) == 0u) { if (xb_ld(&bar[XB_TMO])) break; if (sp > XB_SPIN_CAP) { atomicAdd(&bar[XB_TMO], 1u); break; } }
    }
    nloc = mine > 0u ? mine : 1u; nx = cnt > 0u ? cnt : 1u;
}
__device__ __forceinline__ void xcd_barrier(const XcdBarrier& b) {
    asm volatile("s_waitcnt vmcnt(0)" ::: "memory");
    __syncthreads();
    if (threadIdx.x == 0) {
        unsigned* bar = b.bar;
        __builtin_amdgcn_s_waitcnt(0);
        unsigned nloc = b.st[0], nx = b.st[1];
        if (nloc == 0u) { xcd_barrier_complete(bar, b.x, nloc, nx); b.st[0] = nloc; b.st[1] = nx; }
        const unsigned old = xb_add(&bar[XB_XSUB(b.x)], 1u);
        const unsigned gen = old / nloc;
        if (old + 1u == (gen + 1u) * nloc) {
            __builtin_amdgcn_fence(__ATOMIC_RELEASE, "agent");
            asm volatile("s_waitcnt vmcnt(0)" ::: "memory");
            const unsigned og = xb_add(&bar[XB_TOP], 1u);
            const unsigned tg = og / nx;
            if (og + 1u == (tg + 1u) * nx) xb_add(&bar[XB_TOPGEN], 1u);
            else XB_SPIN(xb_ld(&bar[XB_TOPGEN]) == tg, bar);
            __builtin_amdgcn_fence(__ATOMIC_ACQUIRE, "agent");
            xb_add(&bar[XB_XGEN(b.x)], 1u);
            asm volatile("s_waitcnt vmcnt(0)" ::: "memory");
        } else {
            XB_SPIN(xb_ld(&bar[XB_XGEN(b.x)]) == gen, bar);
            __builtin_amdgcn_fence(__ATOMIC_ACQUIRE, "agent");
            asm volatile("s_waitcnt vmcnt(0)" ::: "memory");
        }
    }
    __syncthreads();
}

#ifndef REP_MASK
#define REP_MASK 0
#endif
__global__ void __launch_bounds__(NTHR, 2) mega(Params p) {
    extern __shared__ __attribute__((aligned(16))) unsigned char lds_raw[];
    LAS unsigned char* lds = (LAS unsigned char*)lds_raw;
    const int lo = p.ph_lo, hi = p.ph_hi;
    if (hi > 1000) cg::this_grid().sync();
    volatile LAS unsigned* bst = (volatile LAS unsigned*)(lds + LDS_BAR_OFF);
    if (threadIdx.x < 4) bst[threadIdx.x] = 0u;
    __syncthreads();
    XcdBarrier bar; bar.bar = (unsigned*)(p.ws + WS_BAR); bar.x = 0; bar.st = bst;
    if (hi - lo > 1 || REP_MASK) bar = xcd_barrier_post((unsigned*)(p.ws + WS_BAR), bst);
#define IN(k) (lo <= (k) && (k) < hi)
#define NREP(k) (((REP_MASK >> (k)) & 1) ? 2 : 1)
#define SEAM(k, r) do { if ((IN(k) && IN((k) + 1)) || (r) + 1 < NREP(k)) xcd_barrier(bar); } while (0)
    for (int r = 0; r < NREP(0); ++r) { if (IN(0)) phase_prep(p, lds); SEAM(0, r); }
    float* x1 = (float*)(p.ws + WS_X1);
    for (int l = 0; l < 2; ++l) {
        const int b = 1 + 4 * l;
        const float* xin = l ? (const float*)x1 : p.x;
        float* xout = l ? p.out : x1;
        for (int r = 0; r < NREP(b); ++r) { if (IN(b)) phase_norm(p, l, xin); SEAM(b, r); }
        for (int r = 0; r < NREP(b + 1); ++r) {
            if (IN(b + 1)) {
                pg8::Gemm g{(const bf16_t*)(p.ws + WS_H), (const bf16_t*)(p.ws + WS_WIN) + (size_t)l * DIN * D_, T_, DIN, D_};
                pg8::StaticOrder S; S.init(T_, DIN, (int)gridDim.x, (int)blockIdx.x);
                pg8::EpiZ E{(bf16_t*)(p.ws + WS_Z), DIN};
                pg8::gemm_phase(lds, g, S, E);
            }
            SEAM(b + 1, r);
        }
        for (int r = 0; r < NREP(b + 2); ++r) { if (IN(b + 2)) phase_mix(p, l, lds); SEAM(b + 2, r); }
        for (int r = 0; r < NREP(b + 3); ++r) {
            if (IN(b + 3)) {
                pg8::Gemm g{(const bf16_t*)(p.ws + WS_Y), (const bf16_t*)(p.ws + WS_WOUT) + (size_t)l * D_ * D_, T_, D_, D_};
                pg8::StaticOrder S; S.init(T_, D_, (int)gridDim.x, (int)blockIdx.x);
                pg8::EpiRes E{xin, xout, (const float*)(p.ws + WS_MOD) + l * DIN + 2 * D_};
                pg8::gemm_phase(lds, g, S, E);
            }
            SEAM(b + 3, r);
        }
    }
    if (IN(9)) phase_final(p);
}

extern "C" void kernel_launch(void* const* d_in, const int* in_sizes, int n_in, void* d_out, int out_size, void* d_ws, size_t ws_size, hipStream_t stream) {
    static int grid_blocks = 0;
    if (!grid_blocks) {
        int dev = 0, cus = 0, per_cu = 0;
        hipGetDevice(&dev);
        hipDeviceGetAttribute(&cus, hipDeviceAttributeMultiprocessorCount, dev);
        if (hipFuncSetAttribute((const void*)mega, hipFuncAttributeMaxDynamicSharedMemorySize, LDS_BYTES) != hipSuccess) fprintf(stderr, "hipFuncSetAttribute failed\n");
        hipOccupancyMaxActiveBlocksPerMultiprocessor(&per_cu, (const void*)mega, NTHR, LDS_BYTES);
        if (per_cu < 1) { fprintf(stderr, "occupancy query says %d blocks/CU\n", per_cu); per_cu = 1; }
        (void)hipGetLastError();
        grid_blocks = cus * per_cu;
        if (ws_size < WS_END) fprintf(stderr, "workspace too small: %zu < %zu\n", ws_size, (size_t)WS_END);
    }
    Params p{};
    const float** pp = (const float**)&p;
    for (int i = 0; i < 21; ++i) pp[i] = (const float*)d_in[i];
    p.out = (float*)d_out; p.ws = (unsigned char*)d_ws;
    (void)hipMemsetAsync((unsigned char*)d_ws + WS_BAR, 0, XCD_BAR_WORDS * 4, stream);
#if MULTI_LAUNCH
    for (int ph = 0; ph < 10; ++ph) { p.ph_lo = ph; p.ph_hi = ph + 1; hipLaunchKernelGGL(mega, dim3(grid_blocks), dim3(NTHR), LDS_BYTES, stream, p); }
#else
    p.ph_lo = 0; p.ph_hi = 10;
    void* args[] = {&p};
    hipError_t e = hipLaunchCooperativeKernel((const void*)mega, dim3(grid_blocks), dim3(NTHR), args, LDS_BYTES, stream);
    if (e != hipSuccess) fprintf(stderr, "cooperative launch failed: %s (grid %d)\n", hipGetErrorString(e), grid_blocks);
#endif
}
```
